# Optimizing an MI355X kernel written in HIP

```python
import jax, jax.numpy as jnp
from jax import lax
import numpy as np

D_MODEL = 1024
BATCH = 8
SEQ = 2048
DEPTH = 2

N_HEADS = 8
HEAD_DIM = 64
D_ATT = N_HEADS * HEAD_DIM
IDX_HEADS = 8
IDX_DIM = 32
TOPK_MAX = 256
Q_BLOCK = 128
D_RNN = 1024
RNN_BLOCKS = 16
RNN_BW = D_RNN // RNN_BLOCKS
CONV_W = 4
LRU_C = 8.0
D_FF = 2816
EPS = 1e-6

SPLITS = (D_ATT, HEAD_DIM, HEAD_DIM, IDX_HEADS * IDX_DIM, IDX_DIM, IDX_HEADS,
          D_RNN, D_RNN, D_MODEL, D_MODEL)
N_IN = sum(SPLITS)

kernel_name = "hybrid_dsa_rglru_macaron"


def rmsnorm(x, g):
    x32 = x.astype(jnp.float32)
    y = x32 * lax.rsqrt(jnp.mean(x32 * x32, axis=-1, keepdims=True) + EPS)
    return (y * g.astype(jnp.float32)).astype(x.dtype)


def swiglu(x, w_gate, w_up, w_down):
    return (jax.nn.silu(x @ w_gate) * (x @ w_up)) @ w_down


def split_columns(z):
    offsets = [int(o) for o in np.cumsum(SPLITS)[:-1]]
    return jnp.split(z, offsets, axis=-1)


def causal_dwconv(x, w, b):
    c = x.shape[-1]
    y = lax.conv_general_dilated(
        x, w[:, None, :], window_strides=(1,), padding=[(CONV_W - 1, 0)],
        dimension_numbers=("NWC", "WIO", "NWC"), feature_group_count=c)
    return y + b


def block_diag_linear(x, w, b):
    bsz, s, _ = x.shape
    xb = x.reshape(bsz, s, RNN_BLOCKS, RNN_BW)
    return jnp.einsum("bsni,nij->bsnj", xb, w).reshape(bsz, s, D_RNN) + b


def rg_lru(x, w_a, b_a, w_x, b_x, lam):
    r = jax.nn.sigmoid(block_diag_linear(x, w_a, b_a).astype(jnp.float32))
    i = jax.nn.sigmoid(block_diag_linear(x, w_x, b_x).astype(jnp.float32))
    log_a = -LRU_C * r * jax.nn.softplus(-lam.astype(jnp.float32))
    a = jnp.exp(log_a)
    u = jnp.sqrt(-jnp.expm1(2.0 * log_a)) * i * x.astype(jnp.float32)

    def combine(left, right):
        a1, b1 = left
        a2, b2 = right
        return a1 * a2, a2 * b1 + b2

    _, h = lax.associative_scan(combine, (a, u), axis=1)
    return h.astype(x.dtype)


def dsa_attention(q, k, v, qi, ki, wi):
    bsz, s = k.shape[0], k.shape[1]
    topk = min(TOPK_MAX, s // 4)
    nb = s // Q_BLOCK
    key_pos = jnp.arange(s)

    def to_blocks(t):
        return jnp.moveaxis(t.reshape((bsz, nb, Q_BLOCK) + t.shape[2:]), 1, 0)

    def one_block(args):
        q_b, qi_b, wi_b, start = args
        q_pos = start + jnp.arange(Q_BLOCK)
        causal = key_pos[None, :] <= q_pos[:, None]
        logits = jnp.einsum("bqhd,bsd->bqhs", qi_b.astype(jnp.float32),
                            ki.astype(jnp.float32)) * (IDX_DIM ** -0.5)
        score = jnp.einsum("bqhs,bqh->bqs", jax.nn.relu(logits), wi_b.astype(jnp.float32))
        score = jnp.where(causal[None], score, -jnp.inf)
        _, idx = lax.top_k(score, topk)
        valid = idx <= q_pos[None, :, None]
        k_sel = jax.vmap(lambda kk, ii: kk[ii])(k, idx)
        v_sel = jax.vmap(lambda vv, ii: vv[ii])(v, idx)
        sc = jnp.einsum("bqhd,bqkd->bqhk", q_b, k_sel).astype(jnp.float32) * (HEAD_DIM ** -0.5)
        sc = jnp.where(valid[:, :, None, :], sc, -jnp.inf)
        p = jax.nn.softmax(sc, axis=-1)
        return jnp.einsum("bqhk,bqkd->bqhd", p.astype(v.dtype), v_sel)

    starts = jnp.arange(nb) * Q_BLOCK
    out = lax.map(one_block, (to_blocks(q), to_blocks(qi), to_blocks(wi), starts))
    return jnp.moveaxis(out, 0, 1).reshape(bsz, s, N_HEADS * HEAD_DIM)


def hybrid_mixer(h, w_in, conv_w, conv_b, rg_wa, rg_ba, rg_wx, rg_bx, rg_lam,
                 w_att_proj, w_rnn_proj, w_out):
    bsz, s, _ = h.shape
    z = h @ w_in
    q, k, v, qi, ki, wi, xr, gr, ga_logit, gr_logit = split_columns(z)
    att = dsa_attention(q.reshape(bsz, s, N_HEADS, HEAD_DIM), k, v,
                        qi.reshape(bsz, s, IDX_HEADS, IDX_DIM), ki,
                        wi * (IDX_HEADS ** -0.5))
    xr = causal_dwconv(xr, conv_w, conv_b)
    rnn = rg_lru(xr, rg_wa, rg_ba, rg_wx, rg_bx, rg_lam) * jax.nn.gelu(gr)
    merged = (jax.nn.sigmoid(ga_logit) * (att @ w_att_proj)
              + jax.nn.sigmoid(gr_logit) * (rnn @ w_rnn_proj))
    return merged @ w_out


def setup_inputs(seed: int = 0) -> dict:
    key = jax.random.key(seed)
    ks = jax.random.split(key, 24)
    f32 = jnp.float32

    def w(k, shape, fan_in):
        return jax.random.normal(k, shape, f32) * (fan_in ** -0.5)

    def gain(k, shape):
        return 1.0 + 0.01 * jax.random.normal(k, shape, f32)

    u = jax.random.uniform(ks[13], (DEPTH, D_RNN), f32, minval=0.9, maxval=0.999)
    a0 = u ** (1.0 / LRU_C)
    lam = jnp.log(a0) - jnp.log1p(-a0)

    return {
        "x": jax.random.normal(ks[0], (BATCH, SEQ, D_MODEL), f32),
        "ffn1_norm": gain(ks[1], (DEPTH, D_MODEL)),
        "ffn1_wg": w(ks[2], (DEPTH, D_MODEL, D_FF), D_MODEL),
        "ffn1_wu": w(ks[3], (DEPTH, D_MODEL, D_FF), D_MODEL),
        "ffn1_wd": w(ks[4], (DEPTH, D_FF, D_MODEL), D_FF),
        "mix_norm": gain(ks[5], (DEPTH, D_MODEL)),
        "w_in": w(ks[6], (DEPTH, D_MODEL, N_IN), D_MODEL),
        "conv_w": w(ks[7], (DEPTH, CONV_W, D_RNN), CONV_W),
        "conv_b": 0.01 * jax.random.normal(ks[8], (DEPTH, D_RNN), f32),
        "rg_wa": w(ks[9], (DEPTH, RNN_BLOCKS, RNN_BW, RNN_BW), RNN_BW),
        "rg_ba": 0.01 * jax.random.normal(ks[10], (DEPTH, D_RNN), f32),
        "rg_wx": w(ks[11], (DEPTH, RNN_BLOCKS, RNN_BW, RNN_BW), RNN_BW),
        "rg_bx": 0.01 * jax.random.normal(ks[12], (DEPTH, D_RNN), f32),
        "rg_lam": lam,
        "w_att_proj": w(ks[14], (DEPTH, D_ATT, D_MODEL), D_ATT),
        "w_rnn_proj": w(ks[15], (DEPTH, D_RNN, D_MODEL), D_RNN),
        "w_out": w(ks[16], (DEPTH, D_MODEL, D_MODEL), D_MODEL),
        "ffn2_norm": gain(ks[17], (DEPTH, D_MODEL)),
        "ffn2_wg": w(ks[18], (DEPTH, D_MODEL, D_FF), D_MODEL),
        "ffn2_wu": w(ks[19], (DEPTH, D_MODEL, D_FF), D_MODEL),
        "ffn2_wd": w(ks[20], (DEPTH, D_FF, D_MODEL), D_FF),
        "final_norm": gain(ks[21], (D_MODEL,)),
    }


def reference(x, ffn1_norm, ffn1_wg, ffn1_wu, ffn1_wd, mix_norm, w_in, conv_w, conv_b,
              rg_wa, rg_ba, rg_wx, rg_bx, rg_lam, w_att_proj, w_rnn_proj, w_out,
              ffn2_norm, ffn2_wg, ffn2_wu, ffn2_wd, final_norm):
    for l in range(DEPTH):
        x = x + 0.5 * swiglu(rmsnorm(x, ffn1_norm[l]), ffn1_wg[l], ffn1_wu[l], ffn1_wd[l])
        x = x + hybrid_mixer(rmsnorm(x, mix_norm[l]), w_in[l], conv_w[l], conv_b[l],
                             rg_wa[l], rg_ba[l], rg_wx[l], rg_bx[l], rg_lam[l],
                             w_att_proj[l], w_rnn_proj[l], w_out[l])
        x = x + 0.5 * swiglu(rmsnorm(x, ffn2_norm[l]), ffn2_wg[l], ffn2_wu[l], ffn2_wd[l])
    return rmsnorm(x, final_norm)
```

```cpp
#include <hip/hip_runtime.h>
#include <hip/hip_cooperative_groups.h>
#include <cstdio>
#include <cstdint>
namespace cg = cooperative_groups;

#define LAS __attribute__((address_space(3)))
typedef unsigned short bf16_t;
typedef short bf16x8 __attribute__((ext_vector_type(8)));
typedef short s16x4 __attribute__((ext_vector_type(4)));
typedef float f32x4 __attribute__((ext_vector_type(4)));
typedef float f32x16 __attribute__((ext_vector_type(16)));
typedef unsigned u32x4 __attribute__((ext_vector_type(4)));
typedef unsigned u32x2 __attribute__((ext_vector_type(2)));

constexpr int BATCH = 8, SEQ = 2048, DM = 1024, MTOK = BATCH * SEQ, DFF = 2816, NGU = 2 * DFF, NWIN = 5120, NWIN_SRC = 5032;
constexpr float EPS = 1e-6f;
constexpr size_t MiB = 1u << 20;
constexpr size_t WS_WGU = 0;
constexpr size_t WS_WD = 44 * MiB;
constexpr size_t WS_WIN = 66 * MiB;
constexpr size_t WS_WAP = 86 * MiB;
constexpr size_t WS_WRP = 88 * MiB;
constexpr size_t WS_WO = 92 * MiB;
constexpr size_t WS_XB = 96 * MiB;
constexpr size_t WS_SSQ = 128 * MiB;
constexpr size_t WS_R = 129 * MiB;
constexpr size_t SLAB = 12 * MiB + MiB / 4, SLAB_E = SLAB / 2, PLANE_E = 2 * MiB;
constexpr size_t WS_QKV0 = WS_R;
constexpr size_t WS_XR0 = WS_R + 4 * MiB;
constexpr size_t WS_GGR0 = WS_R + 8 * MiB;
constexpr size_t WS_VT0 = WS_R + 12 * MiB;
constexpr size_t GAP_H = SLAB - (size_t)SEQ * DFF * 2, GAP_P = SLAB - (size_t)SEQ * 1024 * 2;
constexpr size_t WS_BAR = WS_R + 98 * MiB;
constexpr size_t WS_ATT = WS_BAR + 49152;
constexpr size_t WS_KI = WS_ATT + 16 * MiB;
constexpr size_t WS_END = WS_KI + 1 * MiB;
constexpr int LDS_BYTES = 147456;

struct Params { const float* in[22]; float* out; unsigned char* ws; };

typedef float f32x2_t __attribute__((ext_vector_type(2)));
typedef __bf16 bf16x2_t __attribute__((ext_vector_type(2)));
__device__ __forceinline__ unsigned cvt_pk_bf16(float lo, float hi) { const f32x2_t v = {lo, hi}; const bf16x2_t b = __builtin_convertvector(v, bf16x2_t); return __builtin_bit_cast(unsigned, b); }
__device__ __forceinline__ unsigned cvt_pk_bf16_asm(float lo, float hi) { unsigned r; asm volatile("s_nop 1\n\tv_cvt_pk_bf16_f32 %0, %1, %2" : "=v"(r) : "v"(lo), "v"(hi)); return r; }
__device__ __forceinline__ size_t prow(int row) { return (size_t)(row >> 11) * SLAB_E + (size_t)(row & 2047) * 1024; }
__device__ __forceinline__ float bf2f(unsigned short b) { return __uint_as_float((unsigned)b << 16); }
__device__ __forceinline__ float bflo(unsigned w) { return __uint_as_float(w << 16); }
__device__ __forceinline__ float bfhi(unsigned w) { return __uint_as_float(w & 0xffff0000u); }
__device__ __forceinline__ float sigmoidf_(float x) { return __builtin_amdgcn_rcpf(1.0f + __expf(-x)); }
__device__ __forceinline__ float gelu_tanh(float x) { const float u = 0.7978845608f * (x + 0.044715f * x * x * x); return x * sigmoidf_(2.0f * u); }
__device__ __forceinline__ float siluf_(float x) { return x * sigmoidf_(x); }

__device__ __forceinline__ int lane_id_() { return (int)__builtin_amdgcn_mbcnt_hi(~0u, __builtin_amdgcn_mbcnt_lo(~0u, 0u)); }
#define MAKE_TID(wv) int tid = (wv) * 64 + lane_id_(); asm volatile("" : "+v"(tid))
namespace pg8 {
constexpr int BM = 256, BK = 64, HALF = 128, HTB = HALF * BK * 2, NXCD = 8, WGM = 8;
__host__ __device__ __forceinline__ int lds_byte(int r, int c) { const int st = (r >> 4) * 2 + (c >> 5), rr = r & 15, cc = c & 31, ob = rr * 64 + cc * 2; return st * 1024 + (ob ^ (((ob >> 9) & 1) << 5)); }
__host__ __device__ __forceinline__ void stage_rc(int b, int& R, int& C) { const int st = b / 1024, sb = b % 1024, swz = sb ^ (((sb >> 9) & 1) << 5); R = (st >> 1) * 16 + swz / 64; C = (st & 1) * 32 + (swz % 64) / 2; }
__host__ __device__ __forceinline__ int perm32(int rho) { const int n = rho >> 4, i = rho & 15; return 8 * (i >> 2) + 4 * n + (i & 3); }
struct Unit { int pm, pn; };
struct Gemm { const bf16_t* A; const bf16_t* Bt; int M, N, K, lda, ldb; size_t gapA = 0; };
struct StaticOrder {
    int nM, nN, nwg, G, c;
    __device__ void init(int M, int N, int G_, int c_) { nM = M / BM; nN = N / BM; nwg = nM * nN; G = G_; c = c_; }
    __device__ bool next(int i, Unit& u) const {
        const long L = (long)i * G + c; if (L >= nwg) return false;
        int wgid = (int)L; { const int q = nwg / NXCD, r = nwg % NXCD, xcd = wgid % NXCD, off = wgid / NXCD; wgid = (xcd < r ? xcd * (q + 1) : r * (q + 1) + (xcd - r) * q) + off; }
        const int nig = WGM * nN, gid = wgid / nig, fm = gid * WGM, gsz = (nM - fm) < WGM ? (nM - fm) : WGM;
        u.pm = fm + ((wgid % nig) % gsz); u.pn = (wgid % nig) / gsz; return true;
    }
};
template <class Epi>
__device__ __forceinline__ void gemm_phase(LAS unsigned char* lds, const Gemm g, const StaticOrder& S, const Epi& E, int wv) {
    MAKE_TID(wv);
    const int wid = __builtin_amdgcn_readfirstlane(tid >> 6), lane = tid & 63, wr = wid >> 2, wc = wid & 3, fr = lane & 15, fq = lane >> 4;
    const int K = g.K, nt = K / BK;
    unsigned voffA[2], voffB[2];
#pragma unroll
    for (int i = 0; i < 2; ++i) { int R, C; stage_rc(tid * 16 + i * 8192, R, C); const int Rb = (R & ~31) + perm32(R & 31);
        voffA[i] = (unsigned)(R * g.lda + C) * 2u; voffB[i] = (unsigned)(Rb * g.ldb + C) * 2u; }
    const size_t kstep = (size_t)(BK * 2);
    const size_t hstepA = (size_t)HALF * g.lda * 2, hstepB = (size_t)HALF * g.ldb * 2;
    const size_t tstepA = 2 * hstepA, tstepB = 2 * hstepB;
    const unsigned ldsw = (unsigned)wid * 1024u;
    const int aoff = lds_byte(wr * 64 + fr, fq * 8), boff = lds_byte(wc * 32 + fr, fq * 8);
#define PG8_SA(b, h) (((b) * 2 + (h)) * HTB)
#define PG8_SB(b, h) ((4 + (b) * 2 + (h)) * HTB)
#define PG8_STAGE(bufoff, gbase, voff) do { _Pragma("unroll") for (int _i = 0; _i < 2; ++_i) \
        __builtin_amdgcn_global_load_lds((const unsigned*)((const char*)(gbase) + (voff)[_i]), (LAS unsigned*)(lds + (bufoff) + ldsw + _i * 8192), 16, 0, 0); } while (0)
#define PG8_LDA(dst, b, h) do { _Pragma("unroll") for (int m = 0; m < 4; ++m) _Pragma("unroll") for (int k = 0; k < 2; ++k) dst[m][k] = *(const LAS bf16x8*)(lds + PG8_SA(b, h) + aoff + m * 2048 + k * 1024); } while (0)
#define PG8_LDB(dst, b, h) do { _Pragma("unroll") for (int n = 0; n < 2; ++n) _Pragma("unroll") for (int k = 0; k < 2; ++k) dst[n][k] = *(const LAS bf16x8*)(lds + PG8_SB(b, h) + boff + n * 2048 + k * 1024); } while (0)
#define PG8_MMA(ai, bj, At, Bt) do { __builtin_amdgcn_s_setprio(1); _Pragma("unroll") for (int m = 0; m < 4; ++m) _Pragma("unroll") for (int n = 0; n < 2; ++n) _Pragma("unroll") for (int k = 0; k < 2; ++k) \
        acc[ai][bj][m][n] = __builtin_amdgcn_mfma_f32_16x16x32_bf16(Bt[n][k], At[m][k], acc[ai][bj][m][n], 0, 0, 0); __builtin_amdgcn_s_setprio(0); } while (0)
#define PG8_WAIT_V(n) asm volatile("s_waitcnt vmcnt(" #n ")" ::: "memory")
#define PG8_WAIT_L(n) asm volatile("s_waitcnt lgkmcnt(" #n ")" ::: "memory")
#define PG8_BAR __builtin_amdgcn_s_barrier()
#define PG8_SCHED __builtin_amdgcn_sched_barrier(0)
    Unit cur, nxt; int ui = 0;
    if (!S.next(0, cur)) return;
    f32x4 acc[2][2][4][2];
#pragma unroll
    for (int a = 0; a < 2; ++a)
#pragma unroll
        for (int b = 0; b < 2; ++b)
#pragma unroll
            for (int m = 0; m < 4; ++m)
#pragma unroll
                for (int n = 0; n < 2; ++n) acc[a][b][m][n] = (f32x4){0.f, 0.f, 0.f, 0.f};
    bf16x8 At[4][2], B0[2][2], B1[2][2];
    const char* cA = (const char*)g.A + (size_t)cur.pm * tstepA + (size_t)(cur.pm >> 3) * g.gapA; const char* cB = (const char*)g.Bt + (size_t)cur.pn * tstepB;
    PG8_STAGE(PG8_SB(0, 0), cB, voffB); PG8_STAGE(PG8_SB(0, 1), cB + hstepB, voffB); PG8_STAGE(PG8_SA(0, 0), cA, voffA); PG8_STAGE(PG8_SA(0, 1), cA + hstepA, voffA);
    if (wr == 1) PG8_BAR;
    PG8_WAIT_V(2); PG8_BAR;
    PG8_STAGE(PG8_SB(1, 0), cB + kstep, voffB); PG8_STAGE(PG8_SA(1, 0), cA + kstep, voffA); PG8_STAGE(PG8_SB(1, 1), cB + hstepB + kstep, voffB);
    PG8_WAIT_V(6); PG8_BAR;
    for (;;) {
        const bool has_next = S.next(ui + 1, nxt);
        const char* nA = has_next ? (const char*)g.A + (size_t)nxt.pm * tstepA + (size_t)(nxt.pm >> 3) * g.gapA : cA; const char* nB = has_next ? (const char*)g.Bt + (size_t)nxt.pn * tstepB : cB;
        for (int t = 0; t < nt; t += 2) {
            const bool last = (t == nt - 2);
            const char* a1 = cA + (size_t)(t + 1) * kstep;
            const char* a2 = last ? nA : cA + (size_t)(t + 2) * kstep; const char* b2 = last ? nB : cB + (size_t)(t + 2) * kstep;
            const char* a3 = a2 + kstep; const char* b3 = b2 + kstep;
            PG8_LDB(B0, 0, 0); PG8_LDB(B1, 0, 1); PG8_SCHED; PG8_LDA(At, 0, 0); PG8_STAGE(PG8_SA(1, 1), a1 + hstepA, voffA);
            PG8_WAIT_V(8); PG8_WAIT_L(0); PG8_BAR; PG8_MMA(0, 0, At, B0); PG8_MMA(0, 1, At, B1); PG8_BAR; PG8_SCHED;
            PG8_LDA(At, 0, 1); PG8_STAGE(PG8_SB(0, 0), b2, voffB); PG8_STAGE(PG8_SB(0, 1), b2 + hstepB, voffB); PG8_STAGE(PG8_SA(0, 0), a2, voffA);
            PG8_WAIT_V(8); PG8_WAIT_L(0); PG8_BAR; PG8_MMA(1, 0, At, B0); PG8_MMA(1, 1, At, B1); PG8_BAR; PG8_SCHED;
            PG8_LDB(B0, 1, 0); PG8_LDB(B1, 1, 1); PG8_SCHED; PG8_LDA(At, 1, 0); PG8_STAGE(PG8_SA(0, 1), a2 + hstepA, voffA);
            PG8_WAIT_V(8); PG8_WAIT_L(0); PG8_BAR; PG8_MMA(0, 0, At, B0); PG8_MMA(0, 1, At, B1); PG8_BAR; PG8_SCHED;
            PG8_LDA(At, 1, 1); PG8_STAGE(PG8_SB(1, 0), b3, voffB); PG8_STAGE(PG8_SB(1, 1), b3 + hstepB, voffB); PG8_STAGE(PG8_SA(1, 0), a3, voffA);
            PG8_WAIT_V(8); PG8_WAIT_L(0); PG8_BAR; PG8_MMA(1, 0, At, B0); PG8_MMA(1, 1, At, B1); PG8_BAR; PG8_SCHED;
        }
        if (wr == 0) PG8_BAR;
        E(acc, cur, wr, wc, fr, fq);
        if (!has_next) break;
#pragma unroll
        for (int a = 0; a < 2; ++a)
#pragma unroll
            for (int b = 0; b < 2; ++b)
#pragma unroll
                for (int m = 0; m < 4; ++m)
#pragma unroll
                    for (int n = 0; n < 2; ++n) acc[a][b][m][n] = (f32x4){0.f, 0.f, 0.f, 0.f};
        cur = nxt; cA = nA; cB = nB; ++ui;
        if (wr == 1) PG8_BAR;
    }
    PG8_WAIT_V(0);
    PG8_BAR;
#undef PG8_SA
#undef PG8_SB
#undef PG8_STAGE
#undef PG8_LDA
#undef PG8_LDB
#undef PG8_MMA
#undef PG8_WAIT_V
#undef PG8_WAIT_L
#undef PG8_BAR
#undef PG8_SCHED
}
}
using pg8::Unit;

__device__ __forceinline__ void panel_barrier(unsigned* gw, unsigned* bar, unsigned target, int wv);
__device__ __forceinline__ float row_rs(const float* ssq, int row) {
    const f32x4* p = (const f32x4*)(ssq + (size_t)row * 16);
    const f32x4 a = p[0], b = p[1], c = p[2], d = p[3];
    const float s = ((a[0] + a[1]) + (a[2] + a[3])) + ((b[0] + b[1]) + (b[2] + b[3])) + ((c[0] + c[1]) + (c[2] + c[3])) + ((d[0] + d[1]) + (d[2] + d[3]));
    return __builtin_amdgcn_rsqf(s * (1.0f / 1024.0f) + EPS);
}

struct EpiSwiGLU {
    bf16_t* H; const float* ssq;
    __device__ __forceinline__ void operator()(const f32x4 (&acc)[2][2][4][2], const Unit& u, int wr, int wc, int fr, int fq) const {
#pragma unroll
        for (int ai = 0; ai < 2; ++ai)
#pragma unroll
            for (int m = 0; m < 4; ++m) {
                const int row = u.pm * 256 + ai * 128 + wr * 64 + m * 16 + fr;
                const float rs = row_rs(ssq, row);
#pragma unroll
                for (int bj = 0; bj < 2; ++bj) {
                    const f32x4 gg = acc[ai][bj][m][0] * rs, uu = acc[ai][bj][m][1] * rs;
                    const int hc = u.pn * 128 + bj * 64 + wc * 16 + fq * 4;
                    const f32x4 t = gg * (-1.44269504089f);
                    f32x4 e; e[0] = __builtin_amdgcn_exp2f(t[0]); e[1] = __builtin_amdgcn_exp2f(t[1]); e[2] = __builtin_amdgcn_exp2f(t[2]); e[3] = __builtin_amdgcn_exp2f(t[3]);
                    const f32x4 d = e + 1.0f;
                    f32x4 r; r[0] = __builtin_amdgcn_rcpf(d[0]); r[1] = __builtin_amdgcn_rcpf(d[1]); r[2] = __builtin_amdgcn_rcpf(d[2]); r[3] = __builtin_amdgcn_rcpf(d[3]);
                    const f32x4 hv = (gg * uu) * r;
                    u32x2 w; w.x = cvt_pk_bf16_asm(hv[0], hv[1]); w.y = cvt_pk_bf16_asm(hv[2], hv[3]);
                    *(u32x2*)(H + (size_t)(row >> 11) * SLAB_E + (size_t)(row & 2047) * DFF + hc) = w;
                }
            }
    }
};

struct EpiResid {
    const float* Xin; float* Xout; bf16_t* XB; float* ssq; float s;
    __device__ __forceinline__ void operator()(const f32x4 (&acc)[2][2][4][2], const Unit& u, int wr, int wc, int fr, int fq) const {
#pragma unroll
        for (int ai = 0; ai < 2; ++ai)
#pragma unroll
            for (int m = 0; m < 4; ++m) {
                const int row = u.pm * 256 + ai * 128 + wr * 64 + m * 16 + fr;
                float q = 0.f;
#pragma unroll
                for (int bj = 0; bj < 2; ++bj) {
                    const int c0 = u.pn * 256 + bj * 128 + wc * 32 + fq * 8;
                    const f32x4 x0 = __builtin_nontemporal_load((const f32x4*)(Xin + (size_t)row * DM + c0)), x1 = __builtin_nontemporal_load((const f32x4*)(Xin + (size_t)row * DM + c0 + 4));
                    const f32x4 y0 = x0 + acc[ai][bj][m][0] * s, y1 = x1 + acc[ai][bj][m][1] * s;
                    *(f32x4*)(Xout + (size_t)row * DM + c0) = y0; *(f32x4*)(Xout + (size_t)row * DM + c0 + 4) = y1;
                    u32x4 w; w.x = cvt_pk_bf16_asm(y0[0], y0[1]); w.y = cvt_pk_bf16_asm(y0[2], y0[3]); w.z = cvt_pk_bf16_asm(y1[0], y1[1]); w.w = cvt_pk_bf16_asm(y1[2], y1[3]);
                    *(u32x4*)(XB + (size_t)row * DM + c0) = w;
                    q += (y0[0] * y0[0] + y0[1] * y0[1]) + (y0[2] * y0[2] + y0[3] * y0[3]) + (y1[0] * y1[0] + y1[1] * y1[1]) + (y1[2] * y1[2] + y1[3] * y1[3]);
                }
                q += __shfl_xor(q, 16); q += __shfl_xor(q, 32);
                if (fq == 0) ssq[(size_t)row * 16 + u.pn * 4 + wc] = q;
            }
    }
};

struct EpiResidFinal {
    const float* Xin; float* Out; float* ssq; const float* g; float s; unsigned* gw; unsigned* bar; unsigned target; int wv;
    __device__ __forceinline__ void operator()(f32x4 (&acc)[2][2][4][2], const Unit& u, int wr, int wc, int fr, int fq) const {
#pragma unroll
        for (int ai = 0; ai < 2; ++ai)
#pragma unroll
            for (int m = 0; m < 4; ++m) {
                const int row = u.pm * 256 + ai * 128 + wr * 64 + m * 16 + fr;
                float q = 0.f;
#pragma unroll
                for (int bj = 0; bj < 2; ++bj) {
                    const int c0 = u.pn * 256 + bj * 128 + wc * 32 + fq * 8;
                    const f32x4 x0 = __builtin_nontemporal_load((const f32x4*)(Xin + (size_t)row * DM + c0)), x1 = __builtin_nontemporal_load((const f32x4*)(Xin + (size_t)row * DM + c0 + 4));
                    const f32x4 y0 = x0 + acc[ai][bj][m][0] * s, y1 = x1 + acc[ai][bj][m][1] * s;
                    acc[ai][bj][m][0] = y0; acc[ai][bj][m][1] = y1;
                    q += (y0[0] * y0[0] + y0[1] * y0[1]) + (y0[2] * y0[2] + y0[3] * y0[3]) + (y1[0] * y1[0] + y1[1] * y1[1]) + (y1[2] * y1[2] + y1[3] * y1[3]);
                }
                q += __shfl_xor(q, 16); q += __shfl_xor(q, 32);
                if (fq == 0) ssq[(size_t)row * 16 + u.pn * 4 + wc] = q;
            }
        panel_barrier(gw, bar, target, wv);
#pragma unroll
        for (int ai = 0; ai < 2; ++ai)
#pragma unroll
            for (int m = 0; m < 4; ++m) {
                const int row = u.pm * 256 + ai * 128 + wr * 64 + m * 16 + fr;
                const float rs = row_rs(ssq, row);
#pragma unroll
                for (int bj = 0; bj < 2; ++bj) {
                    const int c0 = u.pn * 256 + bj * 128 + wc * 32 + fq * 8;
                    const f32x4 g0 = *(const f32x4*)(g + c0), g1 = *(const f32x4*)(g + c0 + 4);
                    *(f32x4*)(Out + (size_t)row * DM + c0) = acc[ai][bj][m][0] * rs * g0;
                    *(f32x4*)(Out + (size_t)row * DM + c0 + 4) = acc[ai][bj][m][1] * rs * g1;
                }
            }
    }
};

struct EpiWin1 {
    bf16_t* R0; bf16_t* VT; bf16_t* KI; const float* ssq;
    __device__ __forceinline__ void operator()(const f32x4 (&acc)[2][2][4][2], const Unit& u, int wr, int wc, int fr, int fq) const {
        bf16_t* dst = R0 + (size_t)(u.pn >> 2) * PLANE_E;
        const bool isg = (u.pn >= 8);
#pragma unroll
        for (int ai = 0; ai < 2; ++ai)
#pragma unroll
            for (int m = 0; m < 4; ++m) {
                const int row = u.pm * 256 + ai * 128 + wr * 64 + m * 16 + fr;
                const float rs = row_rs(ssq, row);
#pragma unroll
                for (int bj = 0; bj < 2; ++bj) {
                    const int c0 = (u.pn & 3) * 256 + bj * 128 + wc * 32 + fq * 8;
                    f32x4 v0 = acc[ai][bj][m][0] * rs, v1 = acc[ai][bj][m][1] * rs;
                    if (isg) {
#pragma unroll
                        for (int j = 0; j < 4; ++j) { v0[j] = gelu_tanh(v0[j]); v1[j] = gelu_tanh(v1[j]); }
                    }
                    u32x4 w; w.x = cvt_pk_bf16_asm(v0[0], v0[1]); w.y = cvt_pk_bf16_asm(v0[2], v0[3]); w.z = cvt_pk_bf16_asm(v1[0], v1[1]); w.w = cvt_pk_bf16_asm(v1[2], v1[3]);
                    *(u32x4*)(dst + prow(row) + c0) = w;
                    if (u.pn == 2 && bj == 1 && wc == 0) *(u32x4*)(KI + (size_t)row * 32 + fq * 8) = w;
                    if (u.pn == 2 && bj == 0 && wc >= 2) {
                        const int d0 = c0 - 576, b = row >> 11, t = row & 2047;
                        bf16_t* vp = VT + (size_t)b * SLAB_E + (size_t)d0 * SEQ + t;
                        vp[0 * SEQ] = (bf16_t)(w.x & 0xffff); vp[1 * SEQ] = (bf16_t)(w.x >> 16); vp[2 * SEQ] = (bf16_t)(w.y & 0xffff); vp[3 * SEQ] = (bf16_t)(w.y >> 16);
                        vp[4 * SEQ] = (bf16_t)(w.z & 0xffff); vp[5 * SEQ] = (bf16_t)(w.z >> 16); vp[6 * SEQ] = (bf16_t)(w.w & 0xffff); vp[7 * SEQ] = (bf16_t)(w.w >> 16);
                    }
                }
            }
    }
};

struct EpiSig {
    bf16_t* dst0; bf16_t* dst1; const float* ssq;
    __device__ __forceinline__ void operator()(const f32x4 (&acc)[2][2][4][2], const Unit& u, int wr, int wc, int fr, int fq) const {
        bf16_t* dst = (u.pn < 4) ? dst0 : dst1;
#pragma unroll
        for (int ai = 0; ai < 2; ++ai)
#pragma unroll
            for (int m = 0; m < 4; ++m) {
                const int row = u.pm * 256 + ai * 128 + wr * 64 + m * 16 + fr;
                const float rs = row_rs(ssq, row);
#pragma unroll
                for (int bj = 0; bj < 2; ++bj) {
                    const int c0 = (u.pn & 3) * 256 + bj * 128 + wc * 32 + fq * 8;
                    f32x4 v0 = acc[ai][bj][m][0] * rs, v1 = acc[ai][bj][m][1] * rs;
#pragma unroll
                    for (int j = 0; j < 4; ++j) { v0[j] = sigmoidf_(v0[j]); v1[j] = sigmoidf_(v1[j]); }
                    u32x4 w; w.x = cvt_pk_bf16_asm(v0[0], v0[1]); w.y = cvt_pk_bf16_asm(v0[2], v0[3]); w.z = cvt_pk_bf16_asm(v1[0], v1[1]); w.w = cvt_pk_bf16_asm(v1[2], v1[3]);
                    *(u32x4*)(dst + prow(row) + c0) = w;
                }
            }
    }
};

template <int MODE> struct EpiGate {
    bf16_t* T; const bf16_t* G;
    __device__ __forceinline__ void operator()(const f32x4 (&acc)[2][2][4][2], const Unit& u, int wr, int wc, int fr, int fq) const {
#pragma unroll
        for (int ai = 0; ai < 2; ++ai)
#pragma unroll
            for (int m = 0; m < 4; ++m) {
                const int row = u.pm * 256 + ai * 128 + wr * 64 + m * 16 + fr;
#pragma unroll
                for (int bj = 0; bj < 2; ++bj) {
                    const int c0 = u.pn * 256 + bj * 128 + wc * 32 + fq * 8;
                    const u32x4 gw = *(const u32x4*)(G + prow(row) + c0);
                    const f32x4 a0 = acc[ai][bj][m][0], a1 = acc[ai][bj][m][1];
                    f32x4 v0, v1;
                    v0[0] = bflo(gw.x) * a0[0]; v0[1] = bfhi(gw.x) * a0[1]; v0[2] = bflo(gw.y) * a0[2]; v0[3] = bfhi(gw.y) * a0[3];
                    v1[0] = bflo(gw.z) * a1[0]; v1[1] = bfhi(gw.z) * a1[1]; v1[2] = bflo(gw.w) * a1[2]; v1[3] = bfhi(gw.w) * a1[3];
                    if (MODE == 1) {
                        const u32x4 tw = *(const u32x4*)(T + prow(row) + c0);
                        v0[0] += bflo(tw.x); v0[1] += bfhi(tw.x); v0[2] += bflo(tw.y); v0[3] += bfhi(tw.y);
                        v1[0] += bflo(tw.z); v1[1] += bfhi(tw.z); v1[2] += bflo(tw.w); v1[3] += bfhi(tw.w);
                    }
                    u32x4 w; w.x = cvt_pk_bf16_asm(v0[0], v0[1]); w.y = cvt_pk_bf16_asm(v0[2], v0[3]); w.z = cvt_pk_bf16_asm(v1[0], v1[1]); w.w = cvt_pk_bf16_asm(v1[2], v1[3]);
                    *(u32x4*)(T + prow(row) + c0) = w;
                }
            }
    }
};

struct CvtJob { const float* s0; const float* s1; const float* gain; bf16_t* dst; int N, K, ldw, kind; };
__device__ __forceinline__ CvtJob get_job(const Params& p, int j) {
    const int l = j >> 3, t = j & 7; CvtJob J; J.s1 = nullptr; J.gain = nullptr; J.kind = 0;
    bf16_t* W = (bf16_t*)p.ws;
    switch (t) {
    case 0: J.s0 = p.in[2] + (size_t)l * DM * DFF; J.s1 = p.in[3] + (size_t)l * DM * DFF; J.gain = p.in[1] + l * DM; J.dst = (bf16_t*)(p.ws + WS_WGU) + (size_t)(l * 2 + 0) * NGU * DM; J.N = NGU; J.K = DM; J.ldw = DFF; J.kind = 1; break;
    case 1: J.s0 = p.in[4] + (size_t)l * DFF * DM; J.dst = (bf16_t*)(p.ws + WS_WD) + (size_t)(l * 2 + 0) * DM * DFF; J.N = DM; J.K = DFF; J.ldw = DM; break;
    case 2: J.s0 = p.in[6] + (size_t)l * DM * NWIN_SRC; J.gain = p.in[5] + l * DM; J.dst = (bf16_t*)(p.ws + WS_WIN) + (size_t)l * NWIN * DM; J.N = NWIN; J.K = DM; J.ldw = NWIN_SRC; J.kind = 2; break;
    case 3: J.s0 = p.in[14] + (size_t)l * 512 * DM; J.dst = (bf16_t*)(p.ws + WS_WAP) + (size_t)l * DM * 512; J.N = DM; J.K = 512; J.ldw = DM; break;
    case 4: J.s0 = p.in[15] + (size_t)l * DM * DM; J.dst = (bf16_t*)(p.ws + WS_WRP) + (size_t)l * DM * DM; J.N = DM; J.K = DM; J.ldw = DM; break;
    case 5: J.s0 = p.in[16] + (size_t)l * DM * DM; J.dst = (bf16_t*)(p.ws + WS_WO) + (size_t)l * DM * DM; J.N = DM; J.K = DM; J.ldw = DM; break;
    case 6: J.s0 = p.in[18] + (size_t)l * DM * DFF; J.s1 = p.in[19] + (size_t)l * DM * DFF; J.gain = p.in[17] + l * DM; J.dst = (bf16_t*)(p.ws + WS_WGU) + (size_t)(l * 2 + 1) * NGU * DM; J.N = NGU; J.K = DM; J.ldw = DFF; J.kind = 1; break;
    default: J.s0 = p.in[20] + (size_t)l * DFF * DM; J.dst = (bf16_t*)(p.ws + WS_WD) + (size_t)(l * 2 + 1) * DM * DFF; J.N = DM; J.K = DFF; J.ldw = DM; break;
    }
    (void)W; return J;
}
__device__ __forceinline__ int job_tiles(int t) {
    switch (t) { case 0: case 6: return (NGU / 256) * (DM / 64); case 1: case 7: return (DM / 256) * (DFF / 64); case 2: return (NWIN / 256) * (DM / 64); case 3: return (DM / 256) * (512 / 64); default: return (DM / 256) * (DM / 64); }
}

__device__ __forceinline__ void convert_jobs(LAS unsigned char* lds, const Params& p, int wv, int jlo, int jhi, int nblk, int bidx) {
    MAKE_TID(wv);
    const int G = nblk, c = bidx;
    constexpr int CT_S = 266;
    LAS unsigned* tile32 = (LAS unsigned*)lds;
    LAS bf16_t* tile = (LAS bf16_t*)lds;
    int tbase = 0;
#pragma unroll 1
    for (int j = jlo; j < jhi; ++j) {
        const int nt = job_tiles(j & 7);
        int first = ((c - tbase) % G + G) % G;
        if (first < nt) {
            const CvtJob J = get_job(p, j);
            const int ktiles = J.K / 64;
            const int n4 = tid & 63, kk0 = tid >> 6;
            f32x4 pv[8];
#define CVT_LOAD(ti_) do { const int n0_ = ((ti_) / ktiles) * 256, k0_ = ((ti_) % ktiles) * 64, pr = n0_ + n4 * 4; \
                const float* src = J.s0; int col = pr; \
                if (J.kind == 1) { const int g32 = pr >> 5, rho = pr & 31; col = g32 * 16 + (rho >> 3) * 4; if ((rho >> 2) & 1) src = J.s1; } \
                else if (J.kind == 2) { if (pr < 640) col = pr; else if (pr < 672) col = 896 + (pr - 640); else if (pr < 680) col = 928 + (pr - 672); else if (pr < 768) col = -1; \
                    else if (pr < 1024) col = 640 + (pr - 768); else col = 936 + (pr - 1024); } \
                _Pragma("unroll") for (int i = 0; i < 8; ++i) { const int kk = kk0 + i * 8; f32x4 v = (f32x4){0.f, 0.f, 0.f, 0.f}; \
                    if (col >= 0) { v = __builtin_nontemporal_load((const f32x4*)(src + (size_t)(k0_ + kk) * J.ldw + col)); if (J.gain) v = v * J.gain[k0_ + kk]; } pv[i] = v; } } while (0)
            CVT_LOAD(first);
            for (int ti = first; ti < nt; ti += G) {
                const int n0 = (ti / ktiles) * 256, k0 = (ti % ktiles) * 64;
#pragma unroll
                for (int i = 0; i < 8; ++i) {
                    tile32[(kk0 + i * 8) * (CT_S / 2) + n4 * 2 + 0] = cvt_pk_bf16(pv[i][0], pv[i][1]);
                    tile32[(kk0 + i * 8) * (CT_S / 2) + n4 * 2 + 1] = cvt_pk_bf16(pv[i][2], pv[i][3]);
                }
                if (ti + G < nt) CVT_LOAD(ti + G);
                __syncthreads();
#pragma unroll
                for (int it = 0; it < 4; ++it) {
                    const int id = it * 512 + tid, n = id >> 3, kc = id & 7;
                    unsigned w[4];
#pragma unroll
                    for (int i = 0; i < 4; ++i) w[i] = (unsigned)tile[(kc * 8 + 2 * i) * CT_S + n] | ((unsigned)tile[(kc * 8 + 2 * i + 1) * CT_S + n] << 16);
                    *(u32x4*)(J.dst + (size_t)(n0 + n) * J.K + k0 + kc * 8) = (u32x4){w[0], w[1], w[2], w[3]};
                }
                __syncthreads();
            }
#undef CVT_LOAD
        }
        tbase += nt;
    }
}

__device__ __forceinline__ void phase_xb(const Params& p, int wv, int c) {
    MAKE_TID(wv);
    const int G = gridDim.x;
    {
        const int wid = tid >> 6, lane = tid & 63;
        const float* X = p.in[0]; bf16_t* XB = (bf16_t*)(p.ws + WS_XB); float* ssq = (float*)(p.ws + WS_SSQ);
        for (int rr = (c >> 3) * 8 + wid; rr < SEQ; rr += (G >> 3) * 8) {
            const int row = (c & 7) * SEQ + rr;
            float q = 0.f;
#pragma unroll
            for (int i = 0; i < 4; ++i) {
                const f32x4 v = __builtin_nontemporal_load((const f32x4*)(X + (size_t)row * DM + i * 256 + lane * 4));
                q += (v[0] * v[0] + v[1] * v[1]) + (v[2] * v[2] + v[3] * v[3]);
                u32x2 w; w.x = cvt_pk_bf16(v[0], v[1]); w.y = cvt_pk_bf16(v[2], v[3]);
                *(u32x2*)(XB + (size_t)row * DM + i * 256 + lane * 4) = w;
            }
#pragma unroll
            for (int o = 32; o >= 1; o >>= 1) q += __shfl_xor(q, o);
            if (lane < 16) ssq[(size_t)row * 16 + lane] = (lane == 0) ? q : 0.f;
        }
    }
}

__device__ __forceinline__ void phase_final(const Params& p, int wv, int c) {
    MAKE_TID(wv);
    const int G = gridDim.x, wid = tid >> 6, lane = tid & 63;
    float* X = p.out; const float* ssq = (const float*)(p.ws + WS_SSQ); const float* g = p.in[21];
    for (int rr = (c >> 3) * 8 + wid; rr < SEQ; rr += (G >> 3) * 8) {
        const int row = (c & 7) * SEQ + rr;
        const float rs = row_rs(ssq, row);
#pragma unroll
        for (int i = 0; i < 4; ++i) {
            f32x4 v = *(const f32x4*)(X + (size_t)row * DM + i * 256 + lane * 4);
            const f32x4 gg = *(const f32x4*)(g + i * 256 + lane * 4);
            v = v * rs * gg;
            *(f32x4*)(X + (size_t)row * DM + i * 256 + lane * 4) = v;
        }
    }
}

__device__ __forceinline__ unsigned f2key(float f) { f += 0.0f; const unsigned u = __float_as_uint(f); return (u & 0x80000000u) ? ~u : (u | 0x80000000u); }
__device__ __forceinline__ int crow(int i, int hi) { return (i & 3) + 8 * (i >> 2) + 4 * hi; }
__device__ __forceinline__ int halfsum(int v) { v += __shfl_xor(v, 1); v += __shfl_xor(v, 2); v += __shfl_xor(v, 4); v += __shfl_xor(v, 8); v += __shfl_xor(v, 16); return v; }

constexpr int AT_KEYS = 8192;
constexpr int AT_MASK = 0, AT_K = 8192, AT_V = 8192 + 2 * 9216, AT_END = 8192 + 4 * 9216;

__device__ __forceinline__ void attn_item(LAS unsigned char* lds, const Params& p, int item, int wv) {
    MAKE_TID(wv);
    const int wid = __builtin_amdgcn_readfirstlane(tid >> 6), lane = tid & 63;
    const int b = item & 7, qblk = item >> 3, t0 = qblk * 32;
    bf16_t* Z = (bf16_t*)(p.ws + WS_QKV0) + (size_t)b * SLAB_E;
    const bf16_t* VT = (const bf16_t*)(p.ws + WS_VT0) + (size_t)b * SLAB_E;
    const bf16_t* KIb = (const bf16_t*)(p.ws + WS_KI) + (size_t)b * SEQ * 32;
    LAS unsigned* maskL = (LAS unsigned*)(lds + AT_MASK);
    const int r = lane & 31, hi = lane >> 5;
    {
        const int g = r >> 3, jj = (r >> 2) & 1, e = r & 3;
        const int hd = (g & 1) * 4 + e;
        const int nkb = qblk + 1;
        const int nch = (nkb + 3) >> 2;
        const int ncm = (((t0 + 32 + 63) >> 6) + 1) >> 1;
        LAS unsigned char* kl = lds + AT_KEYS + wid * 16384 + lane * 16;
#pragma unroll 1
        for (int q = 0; q < 2; ++q) {
            const int tqq = t0 + 4 * wid + 2 * hi + q;
            const int tqrow = t0 + 4 * wid + 2 * jj + ((g >> 1) ^ q);
            const bf16x8 af0 = *(const bf16x8*)(Z + (size_t)tqrow * 1024 + 768 + hd * 32 + hi * 16);
            const bf16x8 af1 = *(const bf16x8*)(Z + (size_t)tqrow * 1024 + 768 + hd * 32 + hi * 16 + 8);
            float wv[8];
            {
                const float sc = 0.35355339059f * 0.17677669529f;
                const u32x4 w = *(const u32x4*)(Z + (size_t)tqq * 1024 + 672);
                wv[0] = bflo(w.x) * sc; wv[1] = bfhi(w.x) * sc; wv[2] = bflo(w.y) * sc; wv[3] = bfhi(w.y) * sc;
                wv[4] = bflo(w.z) * sc; wv[5] = bfhi(w.z) * sc; wv[6] = bflo(w.w) * sc; wv[7] = bfhi(w.w) * sc;
            }
            unsigned kmax = 0u;
            bf16x8 nf0[4], nf1[4];
#pragma unroll
            for (int kk = 0; kk < 4; ++kk) {
                const bf16_t* kp = KIb + (size_t)(kk * 32 + r) * 32 + hi * 16;
                nf0[kk] = *(const bf16x8*)kp; nf1[kk] = *(const bf16x8*)(kp + 8);
            }
#pragma unroll 1
            for (int c4 = 0; c4 < nch; ++c4) {
                bf16x8 bf0[4], bf1[4];
#pragma unroll
                for (int kk = 0; kk < 4; ++kk) { bf0[kk] = nf0[kk]; bf1[kk] = nf1[kk]; }
                if (c4 + 1 < nch) {
#pragma unroll
                    for (int kk = 0; kk < 4; ++kk) {
                        const bf16_t* kp = KIb + (size_t)(((c4 + 1) * 4 + kk) * 32 + r) * 32 + hi * 16;
                        nf0[kk] = *(const bf16x8*)kp; nf1[kk] = *(const bf16x8*)(kp + 8);
                    }
                }
                unsigned kv[4];
#pragma unroll
                for (int kk = 0; kk < 4; ++kk) {
                    f32x16 cc;
#pragma unroll
                    for (int i = 0; i < 16; ++i) cc[i] = 0.f;
                    cc = __builtin_amdgcn_mfma_f32_32x32x16_bf16(af0, bf0[kk], cc, 0, 0, 0);
                    cc = __builtin_amdgcn_mfma_f32_32x32x16_bf16(af1, bf1[kk], cc, 0, 0, 0);
                    float s0 = 0.f;
#pragma unroll
                    for (int i = 0; i < 8; ++i) s0 += fmaxf(cc[i], 0.f) * wv[i];
                    const int sp = (c4 * 4 + kk) * 32 + r;
                    kv[kk] = (sp <= tqq) ? f2key(s0) : 0u;
                }
                *(LAS u32x4*)(kl + c4 * 1024) = (u32x4){kv[0], kv[1], kv[2], kv[3]};
                kmax = max(max(kmax, kv[0]), max(max(kv[1], kv[2]), kv[3]));
            }
            unsigned pre0 = 1u;
            if (qblk >= 8) {
                pre0 = 0u;
                int bit0 = 31;
                {
                    unsigned km = kmax;
                    km = max(km, (unsigned)__builtin_amdgcn_update_dpp(0, (int)km, 0x128, 0xf, 0xf, false)); km = max(km, (unsigned)__builtin_amdgcn_update_dpp(0, (int)km, 0x124, 0xf, 0xf, false));
                    km = max(km, (unsigned)__builtin_amdgcn_update_dpp(0, (int)km, 0x122, 0xf, 0xf, false)); km = max(km, (unsigned)__builtin_amdgcn_update_dpp(0, (int)km, 0x121, 0xf, 0xf, false));
                    const unsigned mlo = max((unsigned)__builtin_amdgcn_readlane((int)km, 0), (unsigned)__builtin_amdgcn_readlane((int)km, 16));
                    const unsigned mhi = max((unsigned)__builtin_amdgcn_readlane((int)km, 32), (unsigned)__builtin_amdgcn_readlane((int)km, 48));
                    const int E = (int)((hi ? mhi : mlo) >> 23);
                    const unsigned e0 = (unsigned)E << 23, e1 = (unsigned)max(E - 1, 0) << 23, e2 = (unsigned)max(E - 2, 0) << 23, e3 = (unsigned)max(E - 3, 0) << 23;
                    int n0 = 0, n1 = 0, n2 = 0, n3 = 0;
#pragma unroll 2
                    for (int c4 = 0; c4 < nch; ++c4) {
                        const u32x4 kq = *(const LAS u32x4*)(kl + c4 * 1024);
#pragma unroll
                        for (int kk = 0; kk < 4; ++kk) { n0 += kq[kk] >= e0 ? 1 : 0; n1 += kq[kk] >= e1 ? 1 : 0; n2 += kq[kk] >= e2 ? 1 : 0; n3 += kq[kk] >= e3 ? 1 : 0; }
                    }
                    unsigned pa = (unsigned)n0 | ((unsigned)n1 << 16), pb = (unsigned)n2 | ((unsigned)n3 << 16);
                    pa += (unsigned)__builtin_amdgcn_update_dpp(0, (int)pa, 0x128, 0xf, 0xf, false); pa += (unsigned)__builtin_amdgcn_update_dpp(0, (int)pa, 0x124, 0xf, 0xf, false);
                    pa += (unsigned)__builtin_amdgcn_update_dpp(0, (int)pa, 0x122, 0xf, 0xf, false); pa += (unsigned)__builtin_amdgcn_update_dpp(0, (int)pa, 0x121, 0xf, 0xf, false);
                    pb += (unsigned)__builtin_amdgcn_update_dpp(0, (int)pb, 0x128, 0xf, 0xf, false); pb += (unsigned)__builtin_amdgcn_update_dpp(0, (int)pb, 0x124, 0xf, 0xf, false);
                    pb += (unsigned)__builtin_amdgcn_update_dpp(0, (int)pb, 0x122, 0xf, 0xf, false); pb += (unsigned)__builtin_amdgcn_update_dpp(0, (int)pb, 0x121, 0xf, 0xf, false);
                    const unsigned alo = (unsigned)__builtin_amdgcn_readlane((int)pa, 0) + (unsigned)__builtin_amdgcn_readlane((int)pa, 16), ahi = (unsigned)__builtin_amdgcn_readlane((int)pa, 32) + (unsigned)__builtin_amdgcn_readlane((int)pa, 48);
                    const unsigned blo = (unsigned)__builtin_amdgcn_readlane((int)pb, 0) + (unsigned)__builtin_amdgcn_readlane((int)pb, 16), bhi = (unsigned)__builtin_amdgcn_readlane((int)pb, 32) + (unsigned)__builtin_amdgcn_readlane((int)pb, 48);
                    const unsigned a = hi ? ahi : alo, b2 = hi ? bhi : blo;
                    const unsigned c0n = a & 0xffffu, c1n = a >> 16, c2n = b2 & 0xffffu, c3n = b2 >> 16;
                    const bool okl = c3n >= 256u;
                    const unsigned pfx = c0n >= 256u ? e0 : (c1n >= 256u ? e1 : (c2n >= 256u ? e2 : e3));
                    if (__builtin_amdgcn_ballot_w64(!okl) == 0ull) { pre0 = pfx; bit0 = 22; }
                }
#pragma unroll 1
                for (int bit = bit0; bit >= 0; --bit) {
                    const unsigned c0 = pre0 | (1u << bit);
                    int nv = 0;
#pragma unroll 2
                    for (int c4 = 0; c4 < nch; ++c4) {
                        const u32x4 kq = *(const LAS u32x4*)(kl + c4 * 1024);
                        nv += (kq[0] >= c0 ? 1 : 0) + (kq[1] >= c0 ? 1 : 0) + (kq[2] >= c0 ? 1 : 0) + (kq[3] >= c0 ? 1 : 0);
                    }
                    nv += __builtin_amdgcn_update_dpp(0, nv, 0x128, 0xf, 0xf, false);
                    nv += __builtin_amdgcn_update_dpp(0, nv, 0x124, 0xf, 0xf, false);
                    nv += __builtin_amdgcn_update_dpp(0, nv, 0x122, 0xf, 0xf, false);
                    nv += __builtin_amdgcn_update_dpp(0, nv, 0x121, 0xf, 0xf, false);
                    const int nlo = __builtin_amdgcn_readlane(nv, 0) + __builtin_amdgcn_readlane(nv, 16);
                    const int nhi = __builtin_amdgcn_readlane(nv, 32) + __builtin_amdgcn_readlane(nv, 48);
                    if ((hi ? nhi : nlo) >= 256) pre0 = c0;
                    if (nlo == 256 && nhi == 256) break;
                }
            }
#pragma unroll 1
            for (int c4 = 0; c4 < ncm; ++c4) {
                u32x4 kq = (u32x4){0u, 0u, 0u, 0u};
                if (c4 < nch) kq = *(const LAS u32x4*)(kl + c4 * 1024);
#pragma unroll
                for (int kk = 0; kk < 4; ++kk) {
                    const unsigned long long m0 = __ballot(kq[kk] >= pre0);
                    if (lane == 0) { maskL[(c4 * 4 + kk) * 32 + 4 * wid + 0 + q] = (unsigned)m0; maskL[(c4 * 4 + kk) * 32 + 4 * wid + 2 + q] = (unsigned)(m0 >> 32); }
                }
            }
        }
    }
    __syncthreads();
    int lane2 = lane; asm volatile("" : "+v"(lane2));
    const int r2 = lane2 & 31, hi2 = lane2 >> 5;
    const int h = wid;
    bf16x8 qf[4];
#pragma unroll
    for (int ks = 0; ks < 4; ++ks) qf[ks] = *(const bf16x8*)(Z + (size_t)(t0 + r2) * 1024 + h * 64 + ks * 16 + hi2 * 8);
    const int ntile = (t0 + 32 + 63) >> 6;
    const int lrow = tid >> 3, lch = tid & 7;
    u32x4 kreg = *(const u32x4*)(Z + (size_t)lrow * 1024 + 512 + lch * 8);
    u32x4 vreg = *(const u32x4*)(VT + (size_t)lrow * SEQ + lch * 8);
    f32x16 o0, o1;
#pragma unroll
    for (int i = 0; i < 16; ++i) { o0[i] = 0.f; o1[i] = 0.f; }
    float m_run = -INFINITY, l_run = 0.f;
    const float qscale = 0.125f * 1.44269504089f;
    for (int kt = 0; kt < ntile; ++kt) {
        LAS unsigned char* Kb = lds + AT_K + (kt & 1) * 9216;
        LAS unsigned char* Vb = lds + AT_V + (kt & 1) * 9216;
        *(LAS u32x4*)(Kb + lrow * 144 + lch * 16) = kreg;
        *(LAS u32x2*)(Vb + lrow * 144 + (lch >> 1) * 32 + (lch & 1) * 8) = (u32x2){vreg.x, vreg.y};
        *(LAS u32x2*)(Vb + lrow * 144 + (lch >> 1) * 32 + (lch & 1) * 8 + 16) = (u32x2){vreg.z, vreg.w};
        if (kt + 1 < ntile) {
            kreg = *(const u32x4*)(Z + (size_t)((kt + 1) * 64 + lrow) * 1024 + 512 + lch * 8);
            vreg = *(const u32x4*)(VT + (size_t)lrow * SEQ + (kt + 1) * 64 + lch * 8);
        }
        __syncthreads();
        f32x16 p0, p1;
#pragma unroll
        for (int i = 0; i < 16; ++i) { p0[i] = 0.f; p1[i] = 0.f; }
#pragma unroll
        for (int ks = 0; ks < 4; ++ks) {
            const bf16x8 ka = *(const LAS bf16x8*)(Kb + r2 * 144 + ks * 32 + hi2 * 16);
            const bf16x8 kb2 = *(const LAS bf16x8*)(Kb + (32 + r2) * 144 + ks * 32 + hi2 * 16);
            p0 = __builtin_amdgcn_mfma_f32_32x32x16_bf16(ka, qf[ks], p0, 0, 0, 0);
            p1 = __builtin_amdgcn_mfma_f32_32x32x16_bf16(kb2, qf[ks], p1, 0, 0, 0);
        }
        const unsigned mw0 = maskL[(kt * 2) * 32 + r2], mw1 = maskL[(kt * 2 + 1) * 32 + r2];
        float mx = -INFINITY;
#pragma unroll
        for (int i = 0; i < 16; ++i) {
            const int bitp = crow(i, 0);
            p0[i] = ((mw0 >> (bitp + 4 * hi2)) & 1u) ? p0[i] : -INFINITY;
            p1[i] = ((mw1 >> (bitp + 4 * hi2)) & 1u) ? p1[i] : -INFINITY;
            mx = fmaxf(mx, fmaxf(p0[i], p1[i]));
        }
        mx = fmaxf(mx, __shfl_xor(mx, 32)) * qscale;
        const float m_new = fmaxf(m_run, mx);
        const float m_use = (m_new == -INFINITY) ? 0.f : m_new;
        const float alpha = __builtin_amdgcn_exp2f(m_run - m_use);
        float ps = 0.f;
#pragma unroll
        for (int i = 0; i < 16; ++i) { p0[i] = __builtin_amdgcn_exp2f(__builtin_fmaf(p0[i], qscale, -m_use)); p1[i] = __builtin_amdgcn_exp2f(__builtin_fmaf(p1[i], qscale, -m_use)); ps += p0[i] + p1[i]; }
        ps += __shfl_xor(ps, 32);
        l_run = l_run * alpha + ps; m_run = m_new;
        if (__builtin_amdgcn_ballot_w64(alpha != 1.0f) != 0ull) {
#pragma unroll
            for (int i = 0; i < 16; ++i) { o0[i] *= alpha; o1[i] *= alpha; }
        }
#pragma unroll
        for (int kb = 0; kb < 2; ++kb)
#pragma unroll
            for (int kk = 0; kk < 2; ++kk) {
                const f32x16& pp = kb ? p1 : p0;
                u32x4 pw;
                pw.x = cvt_pk_bf16(pp[8 * kk + 0], pp[8 * kk + 1]); pw.y = cvt_pk_bf16(pp[8 * kk + 2], pp[8 * kk + 3]);
                pw.z = cvt_pk_bf16(pp[8 * kk + 4], pp[8 * kk + 5]); pw.w = cvt_pk_bf16(pp[8 * kk + 6], pp[8 * kk + 7]);
                const bf16x8 pb = __builtin_bit_cast(bf16x8, pw);
                const int goff = (kb * 2 + kk) * 32 + hi2 * 16;
#pragma unroll
                for (int db = 0; db < 2; ++db) {
                    const bf16x8 vf = *(const LAS bf16x8*)(Vb + (db * 32 + r2) * 144 + goff);
                    if (db == 0) o0 = __builtin_amdgcn_mfma_f32_32x32x16_bf16(vf, pb, o0, 0, 0, 0);
                    else o1 = __builtin_amdgcn_mfma_f32_32x32x16_bf16(vf, pb, o1, 0, 0, 0);
                }
            }
    }
    {
        const float inv = 1.0f / l_run;
        bf16_t* op = (bf16_t*)(p.ws + WS_ATT) + (size_t)(b * SEQ + t0 + r2) * 512 + h * 64;
#pragma unroll
        for (int g4 = 0; g4 < 4; ++g4) {
            u32x2 w0, w1;
            w0.x = cvt_pk_bf16(o0[4 * g4 + 0] * inv, o0[4 * g4 + 1] * inv); w0.y = cvt_pk_bf16(o0[4 * g4 + 2] * inv, o0[4 * g4 + 3] * inv);
            w1.x = cvt_pk_bf16(o1[4 * g4 + 0] * inv, o1[4 * g4 + 1] * inv); w1.y = cvt_pk_bf16(o1[4 * g4 + 2] * inv, o1[4 * g4 + 3] * inv);
            *(u32x2*)(op + 8 * g4 + 4 * hi2) = w0;
            *(u32x2*)(op + 32 + 8 * g4 + 4 * hi2) = w1;
        }
    }
    __syncthreads();
}

constexpr int RN_Y = 0;
constexpr int RN_A = 36864;
constexpr int RN_U = RN_A + 32768;
constexpr int RN_SA = RN_U + 32768;
constexpr int RN_SH = RN_SA + 2048;
constexpr int RN_HI = RN_SH + 2048;
constexpr int RN_WF = RN_HI + 2048;
constexpr int RN_CW = RN_WF + 8192;
constexpr int RN_END = RN_CW + 1280;

__device__ __forceinline__ void rnn_item(LAS unsigned char* lds, const Params& p, int layer, int item, int wv) {
    MAKE_TID(wv);
    const int wid = __builtin_amdgcn_readfirstlane(tid >> 6), lane = tid & 63;
    const int b = item >> 5, n = (item >> 1) & 15, half = item & 1;
    const bf16_t* XR = (const bf16_t*)(p.ws + WS_XR0) + (size_t)b * SLAB_E + n * 64;
    bf16_t* GG = (bf16_t*)(p.ws + WS_GGR0) + (size_t)b * SLAB_E + n * 64 + half * 32;
    const float* cw = p.in[7] + (size_t)layer * 4 * 1024 + n * 64;
    const float* cb = p.in[8] + (size_t)layer * 1024 + n * 64;
    const float* wa = p.in[9] + ((size_t)layer * 16 + n) * 4096;
    const float* ba = p.in[10] + (size_t)layer * 1024 + n * 64 + half * 32;
    const float* wx = p.in[11] + ((size_t)layer * 16 + n) * 4096;
    const float* bx = p.in[12] + (size_t)layer * 1024 + n * 64 + half * 32;
    const float* lam = p.in[13] + (size_t)layer * 1024 + n * 64 + half * 32;
    LAS bf16_t* Y = (LAS bf16_t*)(lds + RN_Y);
    LAS float* As = (LAS float*)(lds + RN_A);
    LAS float* Us = (LAS float*)(lds + RN_U);
    LAS float* SA = (LAS float*)(lds + RN_SA);
    LAS float* SH = (LAS float*)(lds + RN_SH);
    LAS float* HI = (LAS float*)(lds + RN_HI);
    const int r = lane & 31, hi = lane >> 5;
    LAS u32x4* WF = (LAS u32x4*)(lds + RN_WF);
    if (wid == 0) {
#pragma unroll
        for (int ks = 0; ks < 4; ++ks) {
            unsigned wA[4], wX[4];
#pragma unroll
            for (int i = 0; i < 4; ++i) {
                const int k = ks * 16 + hi * 8 + 2 * i;
                wA[i] = cvt_pk_bf16(wa[(size_t)k * 64 + half * 32 + r], wa[(size_t)(k + 1) * 64 + half * 32 + r]);
                wX[i] = cvt_pk_bf16(wx[(size_t)k * 64 + half * 32 + r], wx[(size_t)(k + 1) * 64 + half * 32 + r]);
            }
            WF[(ks * 2 + 0) * 64 + lane] = (u32x4){wA[0], wA[1], wA[2], wA[3]};
            WF[(ks * 2 + 1) * 64 + lane] = (u32x4){wX[0], wX[1], wX[2], wX[3]};
        }
    }
    LAS float* CW = (LAS float*)(lds + RN_CW);
    if (tid < 256) CW[tid] = cw[(tid >> 6) * 1024 + (tid & 63)]; else if (tid < 320) CW[tid] = cb[tid - 256];
    const float bav = ba[r], bxv = bx[r];
    const float spl = log1pf(__expf(-lam[r]));
    float hcar = 0.f;
    __syncthreads();
    for (int tt = 0; tt < SEQ / 256; ++tt) {
        const int tb = tt * 256;
        {
            const int tok = tid >> 1, cg0 = (tid & 1) * 32, t = tb + tok;
#pragma unroll
            for (int hq = 0; hq < 2; ++hq) {
                u32x4 xw[2][4];
#pragma unroll
                for (int q8 = 0; q8 < 2; ++q8)
#pragma unroll
                    for (int j = 0; j < 4; ++j) { const int ts = t - 3 + j; xw[q8][j] = *(const u32x4*)(XR + (size_t)(ts < 0 ? 0 : ts) * 1024 + cg0 + (hq * 2 + q8) * 8); }
                __builtin_amdgcn_sched_barrier(0);
#pragma unroll
                for (int q8 = 0; q8 < 2; ++q8) {
                    const int c0 = cg0 + (hq * 2 + q8) * 8;
                    float y[8];
#pragma unroll
                    for (int i = 0; i < 8; ++i) y[i] = CW[256 + c0 + i];
#pragma unroll
                    for (int j = 0; j < 4; ++j) {
                        const float mk = (t - 3 + j) >= 0 ? 1.0f : 0.0f;
                        const u32x4 x4 = xw[q8][j];
                        const f32x4 w0 = *(const LAS f32x4*)(CW + j * 64 + c0) * mk, w1 = *(const LAS f32x4*)(CW + j * 64 + c0 + 4) * mk;
                        y[0] += w0[0] * bflo(x4.x); y[1] += w0[1] * bfhi(x4.x); y[2] += w0[2] * bflo(x4.y); y[3] += w0[3] * bfhi(x4.y);
                        y[4] += w1[0] * bflo(x4.z); y[5] += w1[1] * bfhi(x4.z); y[6] += w1[2] * bflo(x4.w); y[7] += w1[3] * bfhi(x4.w);
                    }
                    u32x4 w; w.x = cvt_pk_bf16(y[0], y[1]); w.y = cvt_pk_bf16(y[2], y[3]); w.z = cvt_pk_bf16(y[4], y[5]); w.w = cvt_pk_bf16(y[6], y[7]);
                    *(LAS u32x4*)(Y + tok * 72 + c0) = w;
                    if ((c0 >> 5) == half) {
#pragma unroll
                        for (int i = 0; i < 8; ++i) Us[tok * 32 + (c0 & 31) + i] = y[i];
                    }
                    __builtin_amdgcn_sched_barrier(0);
                }
            }
        }
        __syncthreads();
        {
            f32x16 ca, cx;
#pragma unroll
            for (int i = 0; i < 16; ++i) { ca[i] = 0.f; cx[i] = 0.f; }
#pragma unroll
            for (int ks = 0; ks < 4; ++ks) {
                const bf16x8 ya = *(const LAS bf16x8*)(Y + (wid * 32 + r) * 72 + ks * 16 + hi * 8);
                const bf16x8 fa = __builtin_bit_cast(bf16x8, WF[(ks * 2 + 0) * 64 + lane]), fx = __builtin_bit_cast(bf16x8, WF[(ks * 2 + 1) * 64 + lane]);
                ca = __builtin_amdgcn_mfma_f32_32x32x16_bf16(ya, fa, ca, 0, 0, 0);
                cx = __builtin_amdgcn_mfma_f32_32x32x16_bf16(ya, fx, cx, 0, 0, 0);
            }
#pragma unroll
            for (int i = 0; i < 16; ++i) {
                const int tok = wid * 32 + crow(i, hi);
                const float rg = sigmoidf_(ca[i] + bav), ig = sigmoidf_(cx[i] + bxv);
                const float la = -8.0f * rg * spl;
                const float a = __expf(la);
                const float mult = __builtin_amdgcn_sqrtf(fmaxf(1.0f - a * a, 0.f));
                const float yv = Us[tok * 32 + r];
                As[tok * 32 + r] = a;
                Us[tok * 32 + r] = mult * ig * yv;
            }
        }
        __syncthreads();
        const int sc = tid & 31, seg = tid >> 5;
        float av[16], uv[16];
#pragma unroll
        for (int k = 0; k < 16; ++k) { av[k] = As[(seg * 16 + k) * 32 + sc]; uv[k] = Us[(seg * 16 + k) * 32 + sc]; }
        bf16_t* gp0 = GG + (size_t)(tb + seg * 16) * 1024 + sc;
        float gv[16];
#pragma unroll
        for (int k = 0; k < 16; ++k) gv[k] = bf2f(gp0[(size_t)k * 1024]);
        {
            float A = 1.f, H = 0.f;
#pragma unroll
            for (int k = 0; k < 16; ++k) { A *= av[k]; H = av[k] * H + uv[k]; }
            SA[seg * 32 + sc] = A; SH[seg * 32 + sc] = H;
        }
        __syncthreads();
        float hin = 0.f;
        {
            float sa[16], sh[16];
#pragma unroll
            for (int s2 = 0; s2 < 16; ++s2) { sa[s2] = SA[s2 * 32 + sc]; sh[s2] = SH[s2 * 32 + sc]; }
            float hh = hcar;
#pragma unroll
            for (int s2 = 0; s2 < 16; ++s2) { if (s2 == seg) hin = hh; hh = sa[s2] * hh + sh[s2]; }
            hcar = hh;
        }
        {
            float hh = hin;
#pragma unroll
            for (int k = 0; k < 16; ++k) {
                hh = av[k] * hh + uv[k];
                gp0[(size_t)k * 1024] = (bf16_t)(cvt_pk_bf16(hh * gv[k], 0.f) & 0xffff);
            }
        }
        __syncthreads();
    }
}

__device__ __forceinline__ int opq(int v) { asm volatile("" : "+s"(v)); return v; }
#define XB_TMO      128
#define XB_XCNT(j)  (256  + 64 * (j))
#define XB_XSUB(j)  (1280 + 64 * (j))
#define XB_XGEN(j)  (2304 + 64 * (j))
#define XB_TOP      3328
#define XB_TOPGEN   3392
#define XCD_BAR_WORDS 3456
#define XB_SPIN_CAP (1u << 20)
__device__ __forceinline__ unsigned xb_ld(unsigned* p)              { return __hip_atomic_load(p, __ATOMIC_RELAXED, __HIP_MEMORY_SCOPE_AGENT); }
__device__ __forceinline__ unsigned xb_add(unsigned* p, unsigned v) { return __hip_atomic_fetch_add(p, v, __ATOMIC_RELAXED, __HIP_MEMORY_SCOPE_AGENT); }
__device__ __forceinline__ unsigned xb_xcc_id() { return (unsigned)__builtin_amdgcn_s_getreg((3 << 11) | 20) & 0xFu; }
#define XB_SPIN(cond, bar) do { unsigned _sp = 0; while (cond) { __builtin_amdgcn_s_sleep(1); \
    if ((++_sp & 255u) == 0u) { if (xb_ld(&(bar)[XB_TMO])) break; if (_sp > XB_SPIN_CAP) { atomicAdd(&(bar)[XB_TMO], 1u); break; } } } } while (0)
__device__ __forceinline__ void xcd_barrier_complete(unsigned* bar, unsigned x, unsigned& nloc, unsigned& nx) {
    const unsigned G = gridDim.x;
    unsigned sum, cnt, mine, sp = 0u;
    for (;;) {
        sum = 0u; cnt = 0u; mine = 0u;
#pragma unroll
        for (unsigned j = 0; j < 16; ++j) { const unsigned c = xb_ld(&bar[XB_XCNT(j)]); sum += c; cnt += (c > 0u) ? 1u : 0u; mine = (j == x) ? c : mine; }
        if (sum == G) break;
        __builtin_amdgcn_s_sleep(1);
        if ((++sp & 255u) == 0u) { if (xb_ld(&bar[XB_TMO])) break; if (sp > XB_SPIN_CAP) { atomicAdd(&bar[XB_TMO], 1u); break; } }
    }
    nloc = mine > 0u ? mine : 1u; nx = cnt > 0u ? cnt : 1u;
}
__device__ __forceinline__ void grid_barrier(unsigned* bar, unsigned xcc, volatile LAS unsigned* st, int wv, bool glob) {
    asm volatile("" : "+s"(xcc));
    asm volatile("s_waitcnt vmcnt(0)" ::: "memory");
    __syncthreads();
    int ln = lane_id_(); asm volatile("" : "+v"(ln)); asm volatile("" : "+s"(wv));
    if (wv == 0 && ln == 0) {
        __builtin_amdgcn_s_waitcnt(0);
        unsigned nloc = st[0], nx = st[1];
        if (nloc == 0u) { xcd_barrier_complete(bar, xcc, nloc, nx); st[0] = nloc; st[1] = nx; }
        const unsigned old = xb_add(&bar[XB_XSUB(xcc)], 1u);
        const unsigned gen = old / nloc;
        if (old + 1u == (gen + 1u) * nloc) {
            if (glob) {
                __builtin_amdgcn_fence(__ATOMIC_RELEASE, "agent");
                asm volatile("s_waitcnt vmcnt(0)" ::: "memory");
                const unsigned og = xb_add(&bar[XB_TOP], 1u);
                const unsigned tg = og / nx;
                if (og + 1u == (tg + 1u) * nx) xb_add(&bar[XB_TOPGEN], 1u);
                else XB_SPIN(xb_ld(&bar[XB_TOPGEN]) == tg, bar);
            }
            __builtin_amdgcn_fence(__ATOMIC_ACQUIRE, "agent");
            xb_add(&bar[XB_XGEN(xcc)], 1u);
            asm volatile("s_waitcnt vmcnt(0)" ::: "memory");
        } else {
            XB_SPIN(xb_ld(&bar[XB_XGEN(xcc)]) == gen, bar);
            __builtin_amdgcn_fence(__ATOMIC_ACQUIRE, "agent");
            asm volatile("s_waitcnt vmcnt(0)" ::: "memory");
        }
    }
    __syncthreads();
}
__device__ __forceinline__ void panel_barrier(unsigned* gw, unsigned* bar, unsigned target, int wv) {
    asm volatile("s_waitcnt vmcnt(0)" ::: "memory");
    __syncthreads();
    int ln = lane_id_(); asm volatile("" : "+v"(ln)); asm volatile("" : "+s"(wv));
    if (wv == 0 && ln == 0) {
        (void)xb_add(gw, 1u);
        XB_SPIN(xb_ld(gw) < target, bar);
        __builtin_amdgcn_fence(__ATOMIC_ACQUIRE, "agent");
        asm volatile("s_waitcnt vmcnt(0)" ::: "memory");
    }
    __syncthreads();
}
__device__ __forceinline__ void cvt_publish(unsigned* flag, int wv) {
    asm volatile("s_waitcnt vmcnt(0)" ::: "memory");
    __syncthreads();
    int ln = lane_id_(); asm volatile("" : "+v"(ln)); asm volatile("" : "+s"(wv));
    if (wv == 0 && ln == 0) { __builtin_amdgcn_fence(__ATOMIC_RELEASE, "agent"); asm volatile("s_waitcnt vmcnt(0)" ::: "memory"); (void)xb_add(flag, 1u); }
}
__device__ __forceinline__ void cvt_wait(unsigned* flag, unsigned* bar, unsigned want, int wv) {
    int ln = lane_id_(); asm volatile("" : "+v"(ln)); asm volatile("" : "+s"(wv));
    if (wv == 0 && ln == 0) { XB_SPIN(xb_ld(flag) < want, bar); __builtin_amdgcn_fence(__ATOMIC_ACQUIRE, "agent"); asm volatile("s_waitcnt vmcnt(0)" ::: "memory"); }
    __syncthreads();
}
__device__ __forceinline__ void block_seam(int wv) {
    asm volatile("s_waitcnt vmcnt(0)" ::: "memory");
    __syncthreads();
    int ln = lane_id_(); asm volatile("" : "+v"(ln)); asm volatile("" : "+s"(wv));
    if (wv == 0 && ln == 0) { __builtin_amdgcn_fence(__ATOMIC_ACQUIRE, "agent"); asm volatile("s_waitcnt vmcnt(0)" ::: "memory"); }
    __syncthreads();
}
#define GRID_SYNC() do { grid_barrier(bar_ctr, xcc_id, bar_st, wv, true); } while (0)
#define GRID_SYNC_P() do { if (fastp) panel_barrier(grp_ctr, bar_ctr, 4u * (++grp_k), wv); else grid_barrier(bar_ctr, xcc_id, bar_st, wv, true); } while (0)
#define GRID_SYNC_L() do { grid_barrier(bar_ctr, xcc_id, bar_st, wv, !fastp); } while (0)
#define Wgu1_(l) ((const bf16_t*)(ws + WS_WGU) + (size_t)(l * 2 + 0) * NGU * DM)
#define Wgu2_(l) ((const bf16_t*)(ws + WS_WGU) + (size_t)(l * 2 + 1) * NGU * DM)
#define Wd1_(l) ((const bf16_t*)(ws + WS_WD) + (size_t)(l * 2 + 0) * DM * DFF)
#define Wd2_(l) ((const bf16_t*)(ws + WS_WD) + (size_t)(l * 2 + 1) * DM * DFF)
#define Win_(l) ((const bf16_t*)(ws + WS_WIN) + (size_t)l * NWIN * DM)
#define Wap_(l) ((const bf16_t*)(ws + WS_WAP) + (size_t)l * DM * 512)
#define Wrp_(l) ((const bf16_t*)(ws + WS_WRP) + (size_t)l * DM * DM)
#define Wo_(l) ((const bf16_t*)(ws + WS_WO) + (size_t)l * DM * DM)
__global__ void __launch_bounds__(512, 2) fwd_megakernel(Params p) {
    extern __shared__ __attribute__((aligned(16))) unsigned char lds_raw[];
    LAS unsigned char* lds = (LAS unsigned char*)lds_raw;
    cg::grid_group grid = cg::this_grid();
    const int G = gridDim.x;
    const int wv = __builtin_amdgcn_readfirstlane((int)(threadIdx.x >> 6));
    unsigned char* ws = p.ws;
    unsigned* bar_ctr = (unsigned*)(ws + WS_BAR);
    volatile LAS unsigned* bar_st = (volatile LAS unsigned*)(lds + LDS_BYTES - 16);
    const unsigned xcc_id = xb_xcc_id();
    if (threadIdx.x == 0) { bar_st[0] = 0u; bar_st[1] = 0u; bar_st[2] = xb_add(&bar_ctr[XB_XCNT(xcc_id)], 1u); }
    __syncthreads();
    const bool split_cvt = (G == 256);
    convert_jobs(lds, p, wv, 0, split_cvt ? 2 : 16, G, (int)blockIdx.x);
    asm volatile("s_waitcnt vmcnt(0)" ::: "memory");
    grid.sync();
    __builtin_amdgcn_fence(__ATOMIC_ACQUIRE, "agent"); asm volatile("s_waitcnt vmcnt(0)" ::: "memory");
    if (threadIdx.x == 0) {
        bool ok = (G % 8 == 0);
#pragma unroll
        for (unsigned j = 0; j < 16; ++j) { const unsigned cn = xb_ld(&bar_ctr[XB_XCNT(j)]); ok = ok && (cn == (j < 8u ? (unsigned)G / 8u : 0u)); }
        bar_st[3] = ok ? 1u : 0u;
    }
    __syncthreads();
    const bool fastp = __builtin_amdgcn_readfirstlane((int)bar_st[3]) != 0;
    const int c = fastp ? __builtin_amdgcn_readfirstlane((int)(bar_st[2] * 8u + xcc_id)) : (int)blockIdx.x;
    unsigned* grp_ctr = bar_ctr + 4096 + 64 * (xcc_id * 8u + (((unsigned)c >> 3) & 7u)); unsigned grp_k = 0u;
    bf16_t* XB = (bf16_t*)(ws + WS_XB); float* SSQ = (float*)(ws + WS_SSQ);
    bf16_t* Hb = (bf16_t*)(ws + WS_R); bf16_t* QKV = (bf16_t*)(ws + WS_QKV0); bf16_t* XRb = (bf16_t*)(ws + WS_XR0); bf16_t* GGR = (bf16_t*)(ws + WS_GGR0); bf16_t* VT = (bf16_t*)(ws + WS_VT0);
    pg8::StaticOrder S;

    phase_xb(p, opq(wv), c);
    GRID_SYNC_L();

    for (int l = 0; l < 2; ++l) {
        if (split_cvt && l == 1) cvt_wait(bar_ctr + 8192 + 64 * 2, bar_ctr, 128u, wv);
        { pg8::Gemm g{XB, Wgu1_(l), MTOK, NGU, DM, DM, DM}; S.init(MTOK, NGU, G, opq(c)); EpiSwiGLU E{Hb, SSQ}; pg8::gemm_phase(lds, g, S, E, wv); }
        if (split_cvt && c >= 128) { if (l == 0) convert_jobs(lds, p, opq(wv), 2, 8, 128, c - 128); else convert_jobs(lds, p, opq(wv), 14, 16, 128, c - 128); cvt_publish(bar_ctr + 8192 + 64 * (l == 0 ? 1 : 3), wv); }
        GRID_SYNC_P();
        { pg8::Gemm g{Hb, Wd1_(l), MTOK, DM, DFF, DFF, DFF, GAP_H}; S.init(MTOK, DM, G, opq(c)); EpiResid E{l == 0 ? p.in[0] : p.out, p.out, XB, SSQ, 0.5f}; pg8::gemm_phase(lds, g, S, E, wv); }
        GRID_SYNC_L();
        if (split_cvt && l == 0) cvt_wait(bar_ctr + 8192 + 64 * 1, bar_ctr, 128u, wv);
        { pg8::Gemm g{XB, Win_(l), MTOK, 3072, DM, DM, DM}; S.init(MTOK, 3072, G, opq(c)); EpiWin1 E{QKV, VT, (bf16_t*)(ws + WS_KI), SSQ}; pg8::gemm_phase(lds, g, S, E, wv); }
        GRID_SYNC_L();
        for (int it = c; it < 512; it += G) {
            const int j = (it >> 3) & 31, b = it & 7, qb = (it >= 256) ? 63 - j : j;
            attn_item(lds, p, qb * 8 + b, wv);
        }
        for (int it = c; it < 256; it += G) rnn_item(lds, p, l, ((it & 7) << 5) | (it >> 3), wv);
        GRID_SYNC_L();
        { pg8::Gemm g{XB, Win_(l) + (size_t)3072 * DM, MTOK, 2048, DM, DM, DM}; S.init(MTOK, 2048, G, opq(c)); EpiSig E{XRb, QKV, SSQ}; pg8::gemm_phase(lds, g, S, E, wv); }
        block_seam(wv);
        { pg8::Gemm g{(const bf16_t*)(ws + WS_ATT), Wap_(l), MTOK, DM, 512, 512, 512}; S.init(MTOK, DM, G, opq(c)); EpiGate<0> E{XRb, XRb}; pg8::gemm_phase(lds, g, S, E, wv); }
        { pg8::Gemm g{GGR, Wrp_(l), MTOK, DM, DM, DM, DM, GAP_P}; S.init(MTOK, DM, G, opq(c)); EpiGate<1> E{XRb, QKV}; pg8::gemm_phase(lds, g, S, E, wv); }
        GRID_SYNC_P();
        { pg8::Gemm g{XRb, Wo_(l), MTOK, DM, DM, DM, DM, GAP_P}; S.init(MTOK, DM, G, opq(c)); EpiResid E{p.out, p.out, XB, SSQ, 1.0f}; pg8::gemm_phase(lds, g, S, E, wv); }
        GRID_SYNC_L();
        if (split_cvt && l == 1) cvt_wait(bar_ctr + 8192 + 64 * 3, bar_ctr, 128u, wv);
        { pg8::Gemm g{XB, Wgu2_(l), MTOK, NGU, DM, DM, DM}; S.init(MTOK, NGU, G, opq(c)); EpiSwiGLU E{Hb, SSQ}; pg8::gemm_phase(lds, g, S, E, wv); }
        if (split_cvt && c >= 128 && l == 0) { convert_jobs(lds, p, opq(wv), 8, 14, 128, c - 128); cvt_publish(bar_ctr + 8192 + 64 * 2, wv); }
        GRID_SYNC_P();
        if (fastp && l == 1) {
            pg8::Gemm g{Hb, Wd2_(l), MTOK, DM, DFF, DFF, DFF, GAP_H}; S.init(MTOK, DM, G, opq(c)); const unsigned tg = 4u * (++grp_k);
            EpiResidFinal E{p.out, p.out, SSQ, p.in[21], 0.5f, grp_ctr, bar_ctr, tg, wv}; pg8::gemm_phase(lds, g, S, E, wv);
        } else {
            { pg8::Gemm g{Hb, Wd2_(l), MTOK, DM, DFF, DFF, DFF, GAP_H}; S.init(MTOK, DM, G, opq(c)); EpiResid E{p.out, p.out, XB, SSQ, 0.5f}; pg8::gemm_phase(lds, g, S, E, wv); }
            if (l == 0) GRID_SYNC_P(); else GRID_SYNC_L();
        }
    }
    if (!fastp) phase_final(p, wv, c);
}

extern "C" void kernel_launch(void* const* d_in, const int* in_sizes, int n_in, void* d_out, int out_size, void* d_ws, size_t ws_size, hipStream_t stream) {
    static int grid_blocks = 0;
    if (grid_blocks == 0) {
        if (n_in != 22 || out_size != MTOK * DM || ws_size < WS_END) { fprintf(stderr, "kernel_launch: unexpected sizes n_in %d out %d ws %zu (need %zu)\n", n_in, out_size, ws_size, (size_t)WS_END); grid_blocks = -1; return; }
        int dev = 0, cus = 0, per_cu = 0;
        hipGetDevice(&dev);
        hipDeviceGetAttribute(&cus, hipDeviceAttributeMultiprocessorCount, dev);
        if (hipFuncSetAttribute((const void*)fwd_megakernel, hipFuncAttributeMaxDynamicSharedMemorySize, LDS_BYTES) != hipSuccess) { fprintf(stderr, "kernel_launch: hipFuncSetAttribute failed\n"); grid_blocks = -1; return; }
        hipOccupancyMaxActiveBlocksPerMultiprocessor(&per_cu, (const void*)fwd_megakernel, 512, LDS_BYTES);
        if (per_cu < 1) { fprintf(stderr, "kernel_launch: occupancy query says %d blocks per CU\n", per_cu); grid_blocks = -1; return; }
        grid_blocks = cus * (per_cu > 1 ? 1 : per_cu);
    }
    if (grid_blocks < 0) return;
    Params p{};
    for (int i = 0; i < 22; ++i) p.in[i] = (const float*)d_in[i];
    p.out = (float*)d_out; p.ws = (unsigned char*)d_ws;
    if (hipMemsetAsync((char*)d_ws + WS_BAR, 0, 49152, stream) != hipSuccess) { fprintf(stderr, "kernel_launch: memset failed\n"); return; }
    void* args[] = {&p};
    hipError_t e = hipLaunchCooperativeKernel((const void*)fwd_megakernel, dim3(grid_blocks), dim3(512), args, LDS_BYTES, stream);
    if (e != hipSuccess) fprintf(stderr, "cooperative launch failed: %s (grid %d)\n", hipGetErrorString(e), grid_blocks);
}
```

```cpp
#include <hip/hip_runtime.h>
#include <hip/hip_cooperative_groups.h>
#include <cstdio>
#include <cstdint>
namespace cg = cooperative_groups;

#define LAS __attribute__((address_space(3)))
typedef unsigned short bf16_t;
typedef short bf16x8 __attribute__((ext_vector_type(8)));
typedef short s16x4 __attribute__((ext_vector_type(4)));
typedef float f32x4 __attribute__((ext_vector_type(4)));
typedef float f32x16 __attribute__((ext_vector_type(16)));
typedef unsigned u32x4 __attribute__((ext_vector_type(4)));
typedef unsigned u32x2 __attribute__((ext_vector_type(2)));

constexpr int BATCH = 8, SEQ = 2048, DM = 1024, MTOK = BATCH * SEQ, DFF = 2816, NGU = 2 * DFF, NWIN = 5120, NWIN_SRC = 5032;
constexpr float EPS = 1e-6f;
constexpr size_t MiB = 1u << 20;
constexpr size_t WS_WGU = 0;
constexpr size_t WS_WD = 44 * MiB;
constexpr size_t WS_WIN = 66 * MiB;
constexpr size_t WS_WAP = 86 * MiB;
constexpr size_t WS_WRP = 88 * MiB;
constexpr size_t WS_WO = 92 * MiB;
constexpr size_t WS_XB = 96 * MiB;
constexpr size_t WS_SSQ = 128 * MiB;
constexpr size_t WS_R = 129 * MiB;
constexpr size_t SLAB = 12 * MiB + MiB / 4, SLAB_E = SLAB / 2, PLANE_E = 2 * MiB;
constexpr size_t WS_QKV0 = WS_R;
constexpr size_t WS_XR0 = WS_R + 4 * MiB;
constexpr size_t WS_GGR0 = WS_R + 8 * MiB;
constexpr size_t WS_VT0 = WS_R + 12 * MiB;
constexpr size_t GAP_H = SLAB - (size_t)SEQ * DFF * 2, GAP_P = SLAB - (size_t)SEQ * 1024 * 2;
constexpr size_t WS_BAR = WS_R + 98 * MiB;
constexpr size_t WS_ATT = WS_BAR + 49152;
constexpr size_t WS_KI = WS_ATT + 16 * MiB;
constexpr size_t WS_END = WS_KI + 1 * MiB;
constexpr int LDS_BYTES = 147456;

struct Params { const float* in[22]; float* out; unsigned char* ws; };

typedef float f32x2_t __attribute__((ext_vector_type(2)));
typedef __bf16 bf16x2_t __attribute__((ext_vector_type(2)));
__device__ __forceinline__ unsigned cvt_pk_bf16(float lo, float hi) { const f32x2_t v = {lo, hi}; const bf16x2_t b = __builtin_convertvector(v, bf16x2_t); return __builtin_bit_cast(unsigned, b); }
__device__ __forceinline__ unsigned cvt_pk_bf16_asm(float lo, float hi) { unsigned r; asm volatile("s_nop 1\n\tv_cvt_pk_bf16_f32 %0, %1, %2" : "=v"(r) : "v"(lo), "v"(hi)); return r; }
__device__ __forceinline__ size_t prow(int row) { return (size_t)(row >> 11) * SLAB_E + (size_t)(row & 2047) * 1024; }
__device__ __forceinline__ float bf2f(unsigned short b) { return __uint_as_float((unsigned)b << 16); }
__device__ __forceinline__ float bflo(unsigned w) { return __uint_as_float(w << 16); }
__device__ __forceinline__ float bfhi(unsigned w) { return __uint_as_float(w & 0xffff0000u); }
__device__ __forceinline__ float sigmoidf_(float x) { return __builtin_amdgcn_rcpf(1.0f + __expf(-x)); }
__device__ __forceinline__ float gelu_tanh(float x) { const float u = 0.7978845608f * (x + 0.044715f * x * x * x); return x * sigmoidf_(2.0f * u); }
__device__ __forceinline__ float siluf_(float x) { return x * sigmoidf_(x); }

__device__ __forceinline__ int lane_id_() { return (int)__builtin_amdgcn_mbcnt_hi(~0u, __builtin_amdgcn_mbcnt_lo(~0u, 0u)); }
#define MAKE_TID(wv) int tid = (wv) * 64 + lane_id_(); asm volatile("" : "+v"(tid))
namespace pg8 {
constexpr int BM = 256, BK = 64, HALF = 128, HTB = HALF * BK * 2, NXCD = 8, WGM = 8;
__host__ __device__ __forceinline__ int lds_byte(int r, int c) { const int st = (r >> 4) * 2 + (c >> 5), rr = r & 15, cc = c & 31, ob = rr * 64 + cc * 2; return st * 1024 + (ob ^ (((ob >> 9) & 1) << 5)); }
__host__ __device__ __forceinline__ void stage_rc(int b, int& R, int& C) { const int st = b / 1024, sb = b % 1024, swz = sb ^ (((sb >> 9) & 1) << 5); R = (st >> 1) * 16 + swz / 64; C = (st & 1) * 32 + (swz % 64) / 2; }
__host__ __device__ __forceinline__ int perm32(int rho) { const int n = rho >> 4, i = rho & 15; return 8 * (i >> 2) + 4 * n + (i & 3); }
struct Unit { int pm, pn; };
struct Gemm { const bf16_t* A; const bf16_t* Bt; int M, N, K, lda, ldb; size_t gapA = 0; };
struct StaticOrder {
    int nM, nN, nwg, G, c;
    __device__ void init(int M, int N, int G_, int c_) { nM = M / BM; nN = N / BM; nwg = nM * nN; G = G_; c = c_; }
    __device__ bool next(int i, Unit& u) const {
        const long L = (long)i * G + c; if (L >= nwg) return false;
        int wgid = (int)L; { const int q = nwg / NXCD, r = nwg % NXCD, xcd = wgid % NXCD, off = wgid / NXCD; wgid = (xcd < r ? xcd * (q + 1) : r * (q + 1) + (xcd - r) * q) + off; }
        const int nig = WGM * nN, gid = wgid / nig, fm = gid * WGM, gsz = (nM - fm) < WGM ? (nM - fm) : WGM;
        u.pm = fm + ((wgid % nig) % gsz); u.pn = (wgid % nig) / gsz; return true;
    }
};
template <class Epi>
__device__ __forceinline__ void gemm_phase(LAS unsigned char* lds, const Gemm g, const StaticOrder& S, const Epi& E, int wv) {
    MAKE_TID(wv);
    const int wid = __builtin_amdgcn_readfirstlane(tid >> 6), lane = tid & 63, wr = wid >> 2, wc = wid & 3, fr = lane & 15, fq = lane >> 4;
    const int K = g.K, nt = K / BK;
    unsigned voffA[2], voffB[2];
#pragma unroll
    for (int i = 0; i < 2; ++i) { int R, C; stage_rc(tid * 16 + i * 8192, R, C); const int Rb = (R & ~31) + perm32(R & 31);
        voffA[i] = (unsigned)(R * g.lda + C) * 2u; voffB[i] = (unsigned)(Rb * g.ldb + C) * 2u; }
    const size_t kstep = (size_t)(BK * 2);
    const size_t hstepA = (size_t)HALF * g.lda * 2, hstepB = (size_t)HALF * g.ldb * 2;
    const size_t tstepA = 2 * hstepA, tstepB = 2 * hstepB;
    const unsigned ldsw = (unsigned)wid * 1024u;
    const int aoff = lds_byte(wr * 64 + fr, fq * 8), boff = lds_byte(wc * 32 + fr, fq * 8);
#define PG8_SA(b, h) (((b) * 2 + (h)) * HTB)
#define PG8_SB(b, h) ((4 + (b) * 2 + (h)) * HTB)
#define PG8_STAGE(bufoff, gbase, voff) do { _Pragma("unroll") for (int _i = 0; _i < 2; ++_i) \
        __builtin_amdgcn_global_load_lds((const unsigned*)((const char*)(gbase) + (voff)[_i]), (LAS unsigned*)(lds + (bufoff) + ldsw + _i * 8192), 16, 0, 0); } while (0)
#define PG8_LDA(dst, b, h) do { _Pragma("unroll") for (int m = 0; m < 4; ++m) _Pragma("unroll") for (int k = 0; k < 2; ++k) dst[m][k] = *(const LAS bf16x8*)(lds + PG8_SA(b, h) + aoff + m * 2048 + k * 1024); } while (0)
#define PG8_LDB(dst, b, h) do { _Pragma("unroll") for (int n = 0; n < 2; ++n) _Pragma("unroll") for (int k = 0; k < 2; ++k) dst[n][k] = *(const LAS bf16x8*)(lds + PG8_SB(b, h) + boff + n * 2048 + k * 1024); } while (0)
#define PG8_MMA(ai, bj, At, Bt) do { __builtin_amdgcn_s_setprio(1); _Pragma("unroll") for (int m = 0; m < 4; ++m) _Pragma("unroll") for (int n = 0; n < 2; ++n) _Pragma("unroll") for (int k = 0; k < 2; ++k) \
        acc[ai][bj][m][n] = __builtin_amdgcn_mfma_f32_16x16x32_bf16(Bt[n][k], At[m][k], acc[ai][bj][m][n], 0, 0, 0); __builtin_amdgcn_s_setprio(0); } while (0)
#define PG8_WAIT_V(n) asm volatile("s_waitcnt vmcnt(" #n ")" ::: "memory")
#define PG8_WAIT_L(n) asm volatile("s_waitcnt lgkmcnt(" #n ")" ::: "memory")
#define PG8_BAR __builtin_amdgcn_s_barrier()
#define PG8_SCHED __builtin_amdgcn_sched_barrier(0)
    Unit cur, nxt; int ui = 0;
    if (!S.next(0, cur)) return;
    f32x4 acc[2][2][4][2];
#pragma unroll
    for (int a = 0; a < 2; ++a)
#pragma unroll
        for (int b = 0; b < 2; ++b)
#pragma unroll
            for (int m = 0; m < 4; ++m)
#pragma unroll
                for (int n = 0; n < 2; ++n) acc[a][b][m][n] = (f32x4){0.f, 0.f, 0.f, 0.f};
    bf16x8 At[4][2], B0[2][2], B1[2][2];
    const char* cA = (const char*)g.A + (size_t)cur.pm * tstepA + (size_t)(cur.pm >> 3) * g.gapA; const char* cB = (const char*)g.Bt + (size_t)cur.pn * tstepB;
    PG8_STAGE(PG8_SB(0, 0), cB, voffB); PG8_STAGE(PG8_SB(0, 1), cB + hstepB, voffB); PG8_STAGE(PG8_SA(0, 0), cA, voffA); PG8_STAGE(PG8_SA(0, 1), cA + hstepA, voffA);
    if (wr == 1) PG8_BAR;
    PG8_WAIT_V(2); PG8_BAR;
    PG8_STAGE(PG8_SB(1, 0), cB + kstep, voffB); PG8_STAGE(PG8_SA(1, 0), cA + kstep, voffA); PG8_STAGE(PG8_SB(1, 1), cB + hstepB + kstep, voffB);
    PG8_WAIT_V(6); PG8_BAR;
    for (;;) {
        const bool has_next = S.next(ui + 1, nxt);
        const char* nA = has_next ? (const char*)g.A + (size_t)nxt.pm * tstepA + (size_t)(nxt.pm >> 3) * g.gapA : cA; const char* nB = has_next ? (const char*)g.Bt + (size_t)nxt.pn * tstepB : cB;
        for (int t = 0; t < nt; t += 2) {
            const bool last = (t == nt - 2);
            const char* a1 = cA + (size_t)(t + 1) * kstep;
            const char* a2 = last ? nA : cA + (size_t)(t + 2) * kstep; const char* b2 = last ? nB : cB + (size_t)(t + 2) * kstep;
            const char* a3 = a2 + kstep; const char* b3 = b2 + kstep;
            PG8_LDB(B0, 0, 0); PG8_LDB(B1, 0, 1); PG8_SCHED; PG8_LDA(At, 0, 0); PG8_STAGE(PG8_SA(1, 1), a1 + hstepA, voffA);
            PG8_WAIT_V(8); PG8_WAIT_L(0); PG8_BAR; PG8_MMA(0, 0, At, B0); PG8_MMA(0, 1, At, B1); PG8_BAR; PG8_SCHED;
            PG8_LDA(At, 0, 1); PG8_STAGE(PG8_SB(0, 0), b2, voffB); PG8_STAGE(PG8_SB(0, 1), b2 + hstepB, voffB); PG8_STAGE(PG8_SA(0, 0), a2, voffA);
            PG8_WAIT_V(8); PG8_WAIT_L(0); PG8_BAR; PG8_MMA(1, 0, At, B0); PG8_MMA(1, 1, At, B1); PG8_BAR; PG8_SCHED;
            PG8_LDB(B0, 1, 0); PG8_LDB(B1, 1, 1); PG8_SCHED; PG8_LDA(At, 1, 0); PG8_STAGE(PG8_SA(0, 1), a2 + hstepA, voffA);
            PG8_WAIT_V(8); PG8_WAIT_L(0); PG8_BAR; PG8_MMA(0, 0, At, B0); PG8_MMA(0, 1, At, B1); PG8_BAR; PG8_SCHED;
            PG8_LDA(At, 1, 1); PG8_STAGE(PG8_SB(1, 0), b3, voffB); PG8_STAGE(PG8_SB(1, 1), b3 + hstepB, voffB); PG8_STAGE(PG8_SA(1, 0), a3, voffA);
            PG8_WAIT_V(8); PG8_WAIT_L(0); PG8_BAR; PG8_MMA(1, 0, At, B0); PG8_MMA(1, 1, At, B1); PG8_BAR; PG8_SCHED;
        }
        if (wr == 0) PG8_BAR;
        E(acc, cur, wr, wc, fr, fq);
        if (!has_next) break;
#pragma unroll
        for (int a = 0; a < 2; ++a)
#pragma unroll
            for (int b = 0; b < 2; ++b)
#pragma unroll
                for (int m = 0; m < 4; ++m)
#pragma unroll
                    for (int n = 0; n < 2; ++n) acc[a][b][m][n] = (f32x4){0.f, 0.f, 0.f, 0.f};
        cur = nxt; cA = nA; cB = nB; ++ui;
        if (wr == 1) PG8_BAR;
    }
    PG8_WAIT_V(0);
    PG8_BAR;
#undef PG8_SA
#undef PG8_SB
#undef PG8_STAGE
#undef PG8_LDA
#undef PG8_LDB
#undef PG8_MMA
#undef PG8_WAIT_V
#undef PG8_WAIT_L
#undef PG8_BAR
#undef PG8_SCHED
}
}
using pg8::Unit;

__device__ __forceinline__ void panel_barrier(unsigned* gw, unsigned* bar, unsigned target, int wv);
__device__ __forceinline__ float row_rs(const float* ssq, int row) {
    const f32x4* p = (const f32x4*)(ssq + (size_t)row * 16);
    const f32x4 a = p[0], b = p[1], c = p[2], d = p[3];
    const float s = ((a[0] + a[1]) + (a[2] + a[3])) + ((b[0] + b[1]) + (b[2] + b[3])) + ((c[0] + c[1]) + (c[2] + c[3])) + ((d[0] + d[1]) + (d[2] + d[3]));
    return __builtin_amdgcn_rsqf(s * (1.0f / 1024.0f) + EPS);
}

struct EpiSwiGLU {
    bf16_t* H; const float* ssq;
    __device__ __forceinline__ void operator()(const f32x4 (&acc)[2][2][4][2], const Unit& u, int wr, int wc, int fr, int fq) const {
#pragma unroll
        for (int ai = 0; ai < 2; ++ai)
#pragma unroll
            for (int m = 0; m < 4; ++m) {
                const int row = u.pm * 256 + ai * 128 + wr * 64 + m * 16 + fr;
                const float rs = row_rs(ssq, row);
#pragma unroll
                for (int bj = 0; bj < 2; ++bj) {
                    const f32x4 gg = acc[ai][bj][m][0] * rs, uu = acc[ai][bj][m][1] * rs;
                    const int hc = u.pn * 128 + bj * 64 + wc * 16 + fq * 4;
                    const f32x4 t = gg * (-1.44269504089f);
                    f32x4 e; e[0] = __builtin_amdgcn_exp2f(t[0]); e[1] = __builtin_amdgcn_exp2f(t[1]); e[2] = __builtin_amdgcn_exp2f(t[2]); e[3] = __builtin_amdgcn_exp2f(t[3]);
                    const f32x4 d = e + 1.0f;
                    f32x4 r; r[0] = __builtin_amdgcn_rcpf(d[0]); r[1] = __builtin_amdgcn_rcpf(d[1]); r[2] = __builtin_amdgcn_rcpf(d[2]); r[3] = __builtin_amdgcn_rcpf(d[3]);
                    const f32x4 hv = (gg * uu) * r;
                    u32x2 w; w.x = cvt_pk_bf16_asm(hv[0], hv[1]); w.y = cvt_pk_bf16_asm(hv[2], hv[3]);
                    *(u32x2*)(H + (size_t)(row >> 11) * SLAB_E + (size_t)(row & 2047) * DFF + hc) = w;
                }
            }
    }
};

struct EpiResid {
    const float* Xin; float* Xout; bf16_t* XB; float* ssq; float s;
    __device__ __forceinline__ void operator()(const f32x4 (&acc)[2][2][4][2], const Unit& u, int wr, int wc, int fr, int fq) const {
#pragma unroll
        for (int ai = 0; ai < 2; ++ai)
#pragma unroll
            for (int m = 0; m < 4; ++m) {
                const int row = u.pm * 256 + ai * 128 + wr * 64 + m * 16 + fr;
                float q = 0.f;
#pragma unroll
                for (int bj = 0; bj < 2; ++bj) {
                    const int c0 = u.pn * 256 + bj * 128 + wc * 32 + fq * 8;
                    const f32x4 x0 = *(const f32x4*)(Xin + (size_t)row * DM + c0), x1 = *(const f32x4*)(Xin + (size_t)row * DM + c0 + 4);
                    const f32x4 y0 = x0 + acc[ai][bj][m][0] * s, y1 = x1 + acc[ai][bj][m][1] * s;
                    *(f32x4*)(Xout + (size_t)row * DM + c0) = y0; *(f32x4*)(Xout + (size_t)row * DM + c0 + 4) = y1;
                    u32x4 w; w.x = cvt_pk_bf16_asm(y0[0], y0[1]); w.y = cvt_pk_bf16_asm(y0[2], y0[3]); w.z = cvt_pk_bf16_asm(y1[0], y1[1]); w.w = cvt_pk_bf16_asm(y1[2], y1[3]);
                    *(u32x4*)(XB + (size_t)row * DM + c0) = w;
                    q += (y0[0] * y0[0] + y0[1] * y0[1]) + (y0[2] * y0[2] + y0[3] * y0[3]) + (y1[0] * y1[0] + y1[1] * y1[1]) + (y1[2] * y1[2] + y1[3] * y1[3]);
                }
                q += __shfl_xor(q, 16); q += __shfl_xor(q, 32);
                if (fq == 0) ssq[(size_t)row * 16 + u.pn * 4 + wc] = q;
            }
    }
};

struct EpiResidFinal {
    const float* Xin; float* Out; float* ssq; const float* g; float s; unsigned* gw; unsigned* bar; unsigned target; int wv;
    __device__ __forceinline__ void operator()(f32x4 (&acc)[2][2][4][2], const Unit& u, int wr, int wc, int fr, int fq) const {
#pragma unroll
        for (int ai = 0; ai < 2; ++ai)
#pragma unroll
            for (int m = 0; m < 4; ++m) {
                const int row = u.pm * 256 + ai * 128 + wr * 64 + m * 16 + fr;
                float q = 0.f;
#pragma unroll
                for (int bj = 0; bj < 2; ++bj) {
                    const int c0 = u.pn * 256 + bj * 128 + wc * 32 + fq * 8;
                    const f32x4 x0 = *(const f32x4*)(Xin + (size_t)row * DM + c0), x1 = *(const f32x4*)(Xin + (size_t)row * DM + c0 + 4);
                    const f32x4 y0 = x0 + acc[ai][bj][m][0] * s, y1 = x1 + acc[ai][bj][m][1] * s;
                    acc[ai][bj][m][0] = y0; acc[ai][bj][m][1] = y1;
                    q += (y0[0] * y0[0] + y0[1] * y0[1]) + (y0[2] * y0[2] + y0[3] * y0[3]) + (y1[0] * y1[0] + y1[1] * y1[1]) + (y1[2] * y1[2] + y1[3] * y1[3]);
                }
                q += __shfl_xor(q, 16); q += __shfl_xor(q, 32);
                if (fq == 0) ssq[(size_t)row * 16 + u.pn * 4 + wc] = q;
            }
        panel_barrier(gw, bar, target, wv);
#pragma unroll
        for (int ai = 0; ai < 2; ++ai)
#pragma unroll
            for (int m = 0; m < 4; ++m) {
                const int row = u.pm * 256 + ai * 128 + wr * 64 + m * 16 + fr;
                const float rs = row_rs(ssq, row);
#pragma unroll
                for (int bj = 0; bj < 2; ++bj) {
                    const int c0 = u.pn * 256 + bj * 128 + wc * 32 + fq * 8;
                    const f32x4 g0 = *(const f32x4*)(g + c0), g1 = *(const f32x4*)(g + c0 + 4);
                    *(f32x4*)(Out + (size_t)row * DM + c0) = acc[ai][bj][m][0] * rs * g0;
                    *(f32x4*)(Out + (size_t)row * DM + c0 + 4) = acc[ai][bj][m][1] * rs * g1;
                }
            }
    }
};

struct EpiWin1 {
    bf16_t* R0; bf16_t* VT; bf16_t* KI; const float* ssq;
    __device__ __forceinline__ void operator()(const f32x4 (&acc)[2][2][4][2], const Unit& u, int wr, int wc, int fr, int fq) const {
        bf16_t* dst = R0 + (size_t)(u.pn >> 2) * PLANE_E;
        const bool isg = (u.pn >= 8);
#pragma unroll
        for (int ai = 0; ai < 2; ++ai)
#pragma unroll
            for (int m = 0; m < 4; ++m) {
                const int row = u.pm * 256 + ai * 128 + wr * 64 + m * 16 + fr;
                const float rs = row_rs(ssq, row);
#pragma unroll
                for (int bj = 0; bj < 2; ++bj) {
                    const int c0 = (u.pn & 3) * 256 + bj * 128 + wc * 32 + fq * 8;
                    f32x4 v0 = acc[ai][bj][m][0] * rs, v1 = acc[ai][bj][m][1] * rs;
                    if (isg) {
#pragma unroll
                        for (int j = 0; j < 4; ++j) { v0[j] = gelu_tanh(v0[j]); v1[j] = gelu_tanh(v1[j]); }
                    }
                    u32x4 w; w.x = cvt_pk_bf16_asm(v0[0], v0[1]); w.y = cvt_pk_bf16_asm(v0[2], v0[3]); w.z = cvt_pk_bf16_asm(v1[0], v1[1]); w.w = cvt_pk_bf16_asm(v1[2], v1[3]);
                    *(u32x4*)(dst + prow(row) + c0) = w;
                    if (u.pn == 2 && bj == 1 && wc == 0) *(u32x4*)(KI + (size_t)row * 32 + fq * 8) = w;
                    if (u.pn == 2 && bj == 0 && wc >= 2) {
                        const int d0 = c0 - 576, b = row >> 11, t = row & 2047;
                        bf16_t* vp = VT + (size_t)b * SLAB_E + (size_t)d0 * SEQ + t;
                        vp[0 * SEQ] = (bf16_t)(w.x & 0xffff); vp[1 * SEQ] = (bf16_t)(w.x >> 16); vp[2 * SEQ] = (bf16_t)(w.y & 0xffff); vp[3 * SEQ] = (bf16_t)(w.y >> 16);
                        vp[4 * SEQ] = (bf16_t)(w.z & 0xffff); vp[5 * SEQ] = (bf16_t)(w.z >> 16); vp[6 * SEQ] = (bf16_t)(w.w & 0xffff); vp[7 * SEQ] = (bf16_t)(w.w >> 16);
                    }
                }
            }
    }
};

struct EpiSig {
    bf16_t* dst0; bf16_t* dst1; const float* ssq;
    __device__ __forceinline__ void operator()(const f32x4 (&acc)[2][2][4][2], const Unit& u, int wr, int wc, int fr, int fq) const {
        bf16_t* dst = (u.pn < 4) ? dst0 : dst1;
#pragma unroll
        for (int ai = 0; ai < 2; ++ai)
#pragma unroll
            for (int m = 0; m < 4; ++m) {
                const int row = u.pm * 256 + ai * 128 + wr * 64 + m * 16 + fr;
                const float rs = row_rs(ssq, row);
#pragma unroll
                for (int bj = 0; bj < 2; ++bj) {
                    const int c0 = (u.pn & 3) * 256 + bj * 128 + wc * 32 + fq * 8;
                    f32x4 v0 = acc[ai][bj][m][0] * rs, v1 = acc[ai][bj][m][1] * rs;
#pragma unroll
                    for (int j = 0; j < 4; ++j) { v0[j] = sigmoidf_(v0[j]); v1[j] = sigmoidf_(v1[j]); }
                    u32x4 w; w.x = cvt_pk_bf16_asm(v0[0], v0[1]); w.y = cvt_pk_bf16_asm(v0[2], v0[3]); w.z = cvt_pk_bf16_asm(v1[0], v1[1]); w.w = cvt_pk_bf16_asm(v1[2], v1[3]);
                    *(u32x4*)(dst + prow(row) + c0) = w;
                }
            }
    }
};

template <int MODE> struct EpiGate {
    bf16_t* T; const bf16_t* G;
    __device__ __forceinline__ void operator()(const f32x4 (&acc)[2][2][4][2], const Unit& u, int wr, int wc, int fr, int fq) const {
#pragma unroll
        for (int ai = 0; ai < 2; ++ai)
#pragma unroll
            for (int m = 0; m < 4; ++m) {
                const int row = u.pm * 256 + ai * 128 + wr * 64 + m * 16 + fr;
#pragma unroll
                for (int bj = 0; bj < 2; ++bj) {
                    const int c0 = u.pn * 256 + bj * 128 + wc * 32 + fq * 8;
                    const u32x4 gw = *(const u32x4*)(G + prow(row) + c0);
                    const f32x4 a0 = acc[ai][bj][m][0], a1 = acc[ai][bj][m][1];
                    f32x4 v0, v1;
                    v0[0] = bflo(gw.x) * a0[0]; v0[1] = bfhi(gw.x) * a0[1]; v0[2] = bflo(gw.y) * a0[2]; v0[3] = bfhi(gw.y) * a0[3];
                    v1[0] = bflo(gw.z) * a1[0]; v1[1] = bfhi(gw.z) * a1[1]; v1[2] = bflo(gw.w) * a1[2]; v1[3] = bfhi(gw.w) * a1[3];
                    if (MODE == 1) {
                        const u32x4 tw = *(const u32x4*)(T + prow(row) + c0);
                        v0[0] += bflo(tw.x); v0[1] += bfhi(tw.x); v0[2] += bflo(tw.y); v0[3] += bfhi(tw.y);
                        v1[0] += bflo(tw.z); v1[1] += bfhi(tw.z); v1[2] += bflo(tw.w); v1[3] += bfhi(tw.w);
                    }
                    u32x4 w; w.x = cvt_pk_bf16_asm(v0[0], v0[1]); w.y = cvt_pk_bf16_asm(v0[2], v0[3]); w.z = cvt_pk_bf16_asm(v1[0], v1[1]); w.w = cvt_pk_bf16_asm(v1[2], v1[3]);
                    *(u32x4*)(T + prow(row) + c0) = w;
                }
            }
    }
};

struct CvtJob { const float* s0; const float* s1; const float* gain; bf16_t* dst; int N, K, ldw, kind; };
__device__ __forceinline__ CvtJob get_job(const Params& p, int j) {
    const int l = j >> 3, t = j & 7; CvtJob J; J.s1 = nullptr; J.gain = nullptr; J.kind = 0;
    bf16_t* W = (bf16_t*)p.ws;
    switch (t) {
    case 0: J.s0 = p.in[2] + (size_t)l * DM * DFF; J.s1 = p.in[3] + (size_t)l * DM * DFF; J.gain = p.in[1] + l * DM; J.dst = (bf16_t*)(p.ws + WS_WGU) + (size_t)(l * 2 + 0) * NGU * DM; J.N = NGU; J.K = DM; J.ldw = DFF; J.kind = 1; break;
    case 1: J.s0 = p.in[4] + (size_t)l * DFF * DM; J.dst = (bf16_t*)(p.ws + WS_WD) + (size_t)(l * 2 + 0) * DM * DFF; J.N = DM; J.K = DFF; J.ldw = DM; break;
    case 2: J.s0 = p.in[6] + (size_t)l * DM * NWIN_SRC; J.gain = p.in[5] + l * DM; J.dst = (bf16_t*)(p.ws + WS_WIN) + (size_t)l * NWIN * DM; J.N = NWIN; J.K = DM; J.ldw = NWIN_SRC; J.kind = 2; break;
    case 3: J.s0 = p.in[14] + (size_t)l * 512 * DM; J.dst = (bf16_t*)(p.ws + WS_WAP) + (size_t)l * DM * 512; J.N = DM; J.K = 512; J.ldw = DM; break;
    case 4: J.s0 = p.in[15] + (size_t)l * DM * DM; J.dst = (bf16_t*)(p.ws + WS_WRP) + (size_t)l * DM * DM; J.N = DM; J.K = DM; J.ldw = DM; break;
    case 5: J.s0 = p.in[16] + (size_t)l * DM * DM; J.dst = (bf16_t*)(p.ws + WS_WO) + (size_t)l * DM * DM; J.N = DM; J.K = DM; J.ldw = DM; break;
    case 6: J.s0 = p.in[18] + (size_t)l * DM * DFF; J.s1 = p.in[19] + (size_t)l * DM * DFF; J.gain = p.in[17] + l * DM; J.dst = (bf16_t*)(p.ws + WS_WGU) + (size_t)(l * 2 + 1) * NGU * DM; J.N = NGU; J.K = DM; J.ldw = DFF; J.kind = 1; break;
    default: J.s0 = p.in[20] + (size_t)l * DFF * DM; J.dst = (bf16_t*)(p.ws + WS_WD) + (size_t)(l * 2 + 1) * DM * DFF; J.N = DM; J.K = DFF; J.ldw = DM; break;
    }
    (void)W; return J;
}
__device__ __forceinline__ int job_tiles(int t) {
    switch (t) { case 0: case 6: return (NGU / 256) * (DM / 64); case 1: case 7: return (DM / 256) * (DFF / 64); case 2: return (NWIN / 256) * (DM / 64); case 3: return (DM / 256) * (512 / 64); default: return (DM / 256) * (DM / 64); }
}

__device__ __forceinline__ void convert_jobs(LAS unsigned char* lds, const Params& p, int wv, int jlo, int jhi, int nblk, int bidx) {
    MAKE_TID(wv);
    const int G = nblk, c = bidx;
    constexpr int CT_S = 266;
    LAS unsigned* tile32 = (LAS unsigned*)lds;
    LAS bf16_t* tile = (LAS bf16_t*)lds;
    int tbase = 0;
#pragma unroll 1
    for (int j = jlo; j < jhi; ++j) {
        const int nt = job_tiles(j & 7);
        int first = ((c - tbase) % G + G) % G;
        if (first < nt) {
            const CvtJob J = get_job(p, j);
            const int ktiles = J.K / 64;
            const int n4 = tid & 63, kk0 = tid >> 6;
            f32x4 pv[8];
#define CVT_LOAD(ti_) do { const int n0_ = ((ti_) / ktiles) * 256, k0_ = ((ti_) % ktiles) * 64, pr = n0_ + n4 * 4; \
                const float* src = J.s0; int col = pr; \
                if (J.kind == 1) { const int g32 = pr >> 5, rho = pr & 31; col = g32 * 16 + (rho >> 3) * 4; if ((rho >> 2) & 1) src = J.s1; } \
                else if (J.kind == 2) { if (pr < 640) col = pr; else if (pr < 672) col = 896 + (pr - 640); else if (pr < 680) col = 928 + (pr - 672); else if (pr < 768) col = -1; \
                    else if (pr < 1024) col = 640 + (pr - 768); else col = 936 + (pr - 1024); } \
                _Pragma("unroll") for (int i = 0; i < 8; ++i) { const int kk = kk0 + i * 8; f32x4 v = (f32x4){0.f, 0.f, 0.f, 0.f}; \
                    if (col >= 0) { v = __builtin_nontemporal_load((const f32x4*)(src + (size_t)(k0_ + kk) * J.ldw + col)); if (J.gain) v = v * J.gain[k0_ + kk]; } pv[i] = v; } } while (0)
            CVT_LOAD(first);
            for (int ti = first; ti < nt; ti += G) {
                const int n0 = (ti / ktiles) * 256, k0 = (ti % ktiles) * 64;
#pragma unroll
                for (int i = 0; i < 8; ++i) {
                    tile32[(kk0 + i * 8) * (CT_S / 2) + n4 * 2 + 0] = cvt_pk_bf16(pv[i][0], pv[i][1]);
                    tile32[(kk0 + i * 8) * (CT_S / 2) + n4 * 2 + 1] = cvt_pk_bf16(pv[i][2], pv[i][3]);
                }
                if (ti + G < nt) CVT_LOAD(ti + G);
                __syncthreads();
#pragma unroll
                for (int it = 0; it < 4; ++it) {
                    const int id = it * 512 + tid, n = id >> 3, kc = id & 7;
                    unsigned w[4];
#pragma unroll
                    for (int i = 0; i < 4; ++i) w[i] = (unsigned)tile[(kc * 8 + 2 * i) * CT_S + n] | ((unsigned)tile[(kc * 8 + 2 * i + 1) * CT_S + n] << 16);
                    { const u32x4 wq = (u32x4){w[0], w[1], w[2], w[3]}; bf16_t* wp = J.dst + (size_t)(n0 + n) * J.K + k0 + kc * 8;
                      asm volatile("global_store_dwordx4 %0, %1, off sc1" :: "v"(wp), "v"(wq) : "memory"); }
                }
                __syncthreads();
            }
#undef CVT_LOAD
        }
        tbase += nt;
    }
}

__device__ __forceinline__ void phase_xb(const Params& p, int wv, int c) {
    MAKE_TID(wv);
    const int G = gridDim.x;
    {
        const int wid = tid >> 6, lane = tid & 63;
        const float* X = p.in[0]; bf16_t* XB = (bf16_t*)(p.ws + WS_XB); float* ssq = (float*)(p.ws + WS_SSQ);
        for (int rr = (c >> 3) * 8 + wid; rr < SEQ; rr += (G >> 3) * 8) {
            const int row = (c & 7) * SEQ + rr;
            float q = 0.f;
#pragma unroll
            for (int i = 0; i < 4; ++i) {
                const f32x4 v = *(const f32x4*)(X + (size_t)row * DM + i * 256 + lane * 4);
                q += (v[0] * v[0] + v[1] * v[1]) + (v[2] * v[2] + v[3] * v[3]);
                u32x2 w; w.x = cvt_pk_bf16(v[0], v[1]); w.y = cvt_pk_bf16(v[2], v[3]);
                *(u32x2*)(XB + (size_t)row * DM + i * 256 + lane * 4) = w;
            }
#pragma unroll
            for (int o = 32; o >= 1; o >>= 1) q += __shfl_xor(q, o);
            if (lane < 16) ssq[(size_t)row * 16 + lane] = (lane == 0) ? q : 0.f;
        }
    }
}

__device__ __forceinline__ void phase_final(const Params& p, int wv, int c) {
    MAKE_TID(wv);
    const int G = gridDim.x, wid = tid >> 6, lane = tid & 63;
    float* X = p.out; const float* ssq = (const float*)(p.ws + WS_SSQ); const float* g = p.in[21];
    for (int rr = (c >> 3) * 8 + wid; rr < SEQ; rr += (G >> 3) * 8) {
        const int row = (c & 7) * SEQ + rr;
        const float rs = row_rs(ssq, row);
#pragma unroll
        for (int i = 0; i < 4; ++i) {
            f32x4 v = *(const f32x4*)(X + (size_t)row * DM + i * 256 + lane * 4);
            const f32x4 gg = *(const f32x4*)(g + i * 256 + lane * 4);
            v = v * rs * gg;
            *(f32x4*)(X + (size_t)row * DM + i * 256 + lane * 4) = v;
        }
    }
}

__device__ __forceinline__ unsigned f2key(float f) { f += 0.0f; const unsigned u = __float_as_uint(f); return (u & 0x80000000u) ? ~u : (u | 0x80000000u); }
__device__ __forceinline__ int crow(int i, int hi) { return (i & 3) + 8 * (i >> 2) + 4 * hi; }
__device__ __forceinline__ int halfsum(int v) { v += __shfl_xor(v, 1); v += __shfl_xor(v, 2); v += __shfl_xor(v, 4); v += __shfl_xor(v, 8); v += __shfl_xor(v, 16); return v; }

constexpr int AT_KEYS = 8192;
constexpr int AT_MASK = 0, AT_K = 8192, AT_V = 8192 + 2 * 9216, AT_END = 8192 + 4 * 9216;

__device__ __forceinline__ void attn_item(LAS unsigned char* lds, const Params& p, int item, int wv) {
    MAKE_TID(wv);
    const int wid = __builtin_amdgcn_readfirstlane(tid >> 6), lane = tid & 63;
    const int b = item & 7, qblk = item >> 3, t0 = qblk * 32;
    bf16_t* Z = (bf16_t*)(p.ws + WS_QKV0) + (size_t)b * SLAB_E;
    const bf16_t* VT = (const bf16_t*)(p.ws + WS_VT0) + (size_t)b * SLAB_E;
    const bf16_t* KIb = (const bf16_t*)(p.ws + WS_KI) + (size_t)b * SEQ * 32;
    LAS unsigned* maskL = (LAS unsigned*)(lds + AT_MASK);
    const int r = lane & 31, hi = lane >> 5;
    {
        const int g = r >> 3, jj = (r >> 2) & 1, e = r & 3;
        const int hd = (g & 1) * 4 + e;
        const int nkb = qblk + 1;
        const int nch = (nkb + 3) >> 2;
        const int ncm = (((t0 + 32 + 63) >> 6) + 1) >> 1;
        LAS unsigned char* kl = lds + AT_KEYS + wid * 16384 + lane * 16;
#pragma unroll 1
        for (int q = 0; q < 2; ++q) {
            const int tqq = t0 + 4 * wid + 2 * hi + q;
            const int tqrow = t0 + 4 * wid + 2 * jj + ((g >> 1) ^ q);
            const bf16x8 af0 = *(const bf16x8*)(Z + (size_t)tqrow * 1024 + 768 + hd * 32 + hi * 16);
            const bf16x8 af1 = *(const bf16x8*)(Z + (size_t)tqrow * 1024 + 768 + hd * 32 + hi * 16 + 8);
            float wv[8];
            {
                const float sc = 0.35355339059f * 0.17677669529f;
                const u32x4 w = *(const u32x4*)(Z + (size_t)tqq * 1024 + 672);
                wv[0] = bflo(w.x) * sc; wv[1] = bfhi(w.x) * sc; wv[2] = bflo(w.y) * sc; wv[3] = bfhi(w.y) * sc;
                wv[4] = bflo(w.z) * sc; wv[5] = bfhi(w.z) * sc; wv[6] = bflo(w.w) * sc; wv[7] = bfhi(w.w) * sc;
            }
            unsigned kmax = 0u;
            bf16x8 nf0[4], nf1[4];
#pragma unroll
            for (int kk = 0; kk < 4; ++kk) {
                const bf16_t* kp = KIb + (size_t)(kk * 32 + r) * 32 + hi * 16;
                nf0[kk] = *(const bf16x8*)kp; nf1[kk] = *(const bf16x8*)(kp + 8);
            }
#pragma unroll 1
            for (int c4 = 0; c4 < nch; ++c4) {
                bf16x8 bf0[4], bf1[4];
#pragma unroll
                for (int kk = 0; kk < 4; ++kk) { bf0[kk] = nf0[kk]; bf1[kk] = nf1[kk]; }
                if (c4 + 1 < nch) {
#pragma unroll
                    for (int kk = 0; kk < 4; ++kk) {
                        const bf16_t* kp = KIb + (size_t)(((c4 + 1) * 4 + kk) * 32 + r) * 32 + hi * 16;
                        nf0[kk] = *(const bf16x8*)kp; nf1[kk] = *(const bf16x8*)(kp + 8);
                    }
                }
                unsigned kv[4];
#pragma unroll
                for (int kk = 0; kk < 4; ++kk) {
                    f32x16 cc;
#pragma unroll
                    for (int i = 0; i < 16; ++i) cc[i] = 0.f;
                    cc = __builtin_amdgcn_mfma_f32_32x32x16_bf16(af0, bf0[kk], cc, 0, 0, 0);
                    cc = __builtin_amdgcn_mfma_f32_32x32x16_bf16(af1, bf1[kk], cc, 0, 0, 0);
                    float s0 = 0.f;
#pragma unroll
                    for (int i = 0; i < 8; ++i) s0 += fmaxf(cc[i], 0.f) * wv[i];
                    const int sp = (c4 * 4 + kk) * 32 + r;
                    kv[kk] = (sp <= tqq) ? f2key(s0) : 0u;
                }
                *(LAS u32x4*)(kl + c4 * 1024) = (u32x4){kv[0], kv[1], kv[2], kv[3]};
                kmax = max(max(kmax, kv[0]), max(max(kv[1], kv[2]), kv[3]));
            }
            unsigned pre0 = 1u;
            if (qblk >= 8) {
                pre0 = 0u;
                int bit0 = 31;
                {
                    unsigned km = kmax;
                    km = max(km, (unsigned)__builtin_amdgcn_update_dpp(0, (int)km, 0x128, 0xf, 0xf, false)); km = max(km, (unsigned)__builtin_amdgcn_update_dpp(0, (int)km, 0x124, 0xf, 0xf, false));
                    km = max(km, (unsigned)__builtin_amdgcn_update_dpp(0, (int)km, 0x122, 0xf, 0xf, false)); km = max(km, (unsigned)__builtin_amdgcn_update_dpp(0, (int)km, 0x121, 0xf, 0xf, false));
                    const unsigned mlo = max((unsigned)__builtin_amdgcn_readlane((int)km, 0), (unsigned)__builtin_amdgcn_readlane((int)km, 16));
                    const unsigned mhi = max((unsigned)__builtin_amdgcn_readlane((int)km, 32), (unsigned)__builtin_amdgcn_readlane((int)km, 48));
                    const int E = (int)((hi ? mhi : mlo) >> 23);
                    const unsigned e0 = (unsigned)E << 23, e1 = (unsigned)max(E - 1, 0) << 23, e2 = (unsigned)max(E - 2, 0) << 23, e3 = (unsigned)max(E - 3, 0) << 23;
                    int n0 = 0, n1 = 0, n2 = 0, n3 = 0;
#pragma unroll 2
                    for (int c4 = 0; c4 < nch; ++c4) {
                        const u32x4 kq = *(const LAS u32x4*)(kl + c4 * 1024);
#pragma unroll
                        for (int kk = 0; kk < 4; ++kk) { n0 += kq[kk] >= e0 ? 1 : 0; n1 += kq[kk] >= e1 ? 1 : 0; n2 += kq[kk] >= e2 ? 1 : 0; n3 += kq[kk] >= e3 ? 1 : 0; }
                    }
                    unsigned pa = (unsigned)n0 | ((unsigned)n1 << 16), pb = (unsigned)n2 | ((unsigned)n3 << 16);
                    pa += (unsigned)__builtin_amdgcn_update_dpp(0, (int)pa, 0x128, 0xf, 0xf, false); pa += (unsigned)__builtin_amdgcn_update_dpp(0, (int)pa, 0x124, 0xf, 0xf, false);
                    pa += (unsigned)__builtin_amdgcn_update_dpp(0, (int)pa, 0x122, 0xf, 0xf, false); pa += (unsigned)__builtin_amdgcn_update_dpp(0, (int)pa, 0x121, 0xf, 0xf, false);
                    pb += (unsigned)__builtin_amdgcn_update_dpp(0, (int)pb, 0x128, 0xf, 0xf, false); pb += (unsigned)__builtin_amdgcn_update_dpp(0, (int)pb, 0x124, 0xf, 0xf, false);
                    pb += (unsigned)__builtin_amdgcn_update_dpp(0, (int)pb, 0x122, 0xf, 0xf, false); pb += (unsigned)__builtin_amdgcn_update_dpp(0, (int)pb, 0x121, 0xf, 0xf, false);
                    const unsigned alo = (unsigned)__builtin_amdgcn_readlane((int)pa, 0) + (unsigned)__builtin_amdgcn_readlane((int)pa, 16), ahi = (unsigned)__builtin_amdgcn_readlane((int)pa, 32) + (unsigned)__builtin_amdgcn_readlane((int)pa, 48);
                    const unsigned blo = (unsigned)__builtin_amdgcn_readlane((int)pb, 0) + (unsigned)__builtin_amdgcn_readlane((int)pb, 16), bhi = (unsigned)__builtin_amdgcn_readlane((int)pb, 32) + (unsigned)__builtin_amdgcn_readlane((int)pb, 48);
                    const unsigned a = hi ? ahi : alo, b2 = hi ? bhi : blo;
                    const unsigned c0n = a & 0xffffu, c1n = a >> 16, c2n = b2 & 0xffffu, c3n = b2 >> 16;
                    const bool okl = c3n >= 256u;
                    const unsigned pfx = c0n >= 256u ? e0 : (c1n >= 256u ? e1 : (c2n >= 256u ? e2 : e3));
                    if (__builtin_amdgcn_ballot_w64(!okl) == 0ull) { pre0 = pfx; bit0 = 22; }
                }
#pragma unroll 1
                for (int bit = bit0; bit >= 0; --bit) {
                    const unsigned c0 = pre0 | (1u << bit);
                    int nv = 0;
#pragma unroll 2
                    for (int c4 = 0; c4 < nch; ++c4) {
                        const u32x4 kq = *(const LAS u32x4*)(kl + c4 * 1024);
                        nv += (kq[0] >= c0 ? 1 : 0) + (kq[1] >= c0 ? 1 : 0) + (kq[2] >= c0 ? 1 : 0) + (kq[3] >= c0 ? 1 : 0);
                    }
                    nv += __builtin_amdgcn_update_dpp(0, nv, 0x128, 0xf, 0xf, false);
                    nv += __builtin_amdgcn_update_dpp(0, nv, 0x124, 0xf, 0xf, false);
                    nv += __builtin_amdgcn_update_dpp(0, nv, 0x122, 0xf, 0xf, false);
                    nv += __builtin_amdgcn_update_dpp(0, nv, 0x121, 0xf, 0xf, false);
                    const int nlo = __builtin_amdgcn_readlane(nv, 0) + __builtin_amdgcn_readlane(nv, 16);
                    const int nhi = __builtin_amdgcn_readlane(nv, 32) + __builtin_amdgcn_readlane(nv, 48);
                    if ((hi ? nhi : nlo) >= 256) pre0 = c0;
                    if (nlo == 256 && nhi == 256) break;
                }
            }
#pragma unroll 1
            for (int c4 = 0; c4 < ncm; ++c4) {
                u32x4 kq = (u32x4){0u, 0u, 0u, 0u};
                if (c4 < nch) kq = *(const LAS u32x4*)(kl + c4 * 1024);
#pragma unroll
                for (int kk = 0; kk < 4; ++kk) {
                    const unsigned long long m0 = __ballot(kq[kk] >= pre0);
                    if (lane == 0) { maskL[(c4 * 4 + kk) * 32 + 4 * wid + 0 + q] = (unsigned)m0; maskL[(c4 * 4 + kk) * 32 + 4 * wid + 2 + q] = (unsigned)(m0 >> 32); }
                }
            }
        }
    }
    __syncthreads();
    int lane2 = lane; asm volatile("" : "+v"(lane2));
    const int r2 = lane2 & 31, hi2 = lane2 >> 5;
    const int h = wid;
    bf16x8 qf[4];
#pragma unroll
    for (int ks = 0; ks < 4; ++ks) qf[ks] = *(const bf16x8*)(Z + (size_t)(t0 + r2) * 1024 + h * 64 + ks * 16 + hi2 * 8);
    const int ntile = (t0 + 32 + 63) >> 6;
    const int lrow = tid >> 3, lch = tid & 7;
    u32x4 kreg = *(const u32x4*)(Z + (size_t)lrow * 1024 + 512 + lch * 8);
    u32x4 vreg = *(const u32x4*)(VT + (size_t)lrow * SEQ + lch * 8);
    f32x16 o0, o1;
#pragma unroll
    for (int i = 0; i < 16; ++i) { o0[i] = 0.f; o1[i] = 0.f; }
    float m_run = -INFINITY, l_run = 0.f;
    const float qscale = 0.125f * 1.44269504089f;
    for (int kt = 0; kt < ntile; ++kt) {
        LAS unsigned char* Kb = lds + AT_K + (kt & 1) * 9216;
        LAS unsigned char* Vb = lds + AT_V + (kt & 1) * 9216;
        *(LAS u32x4*)(Kb + lrow * 144 + lch * 16) = kreg;
        *(LAS u32x2*)(Vb + lrow * 144 + (lch >> 1) * 32 + (lch & 1) * 8) = (u32x2){vreg.x, vreg.y};
        *(LAS u32x2*)(Vb + lrow * 144 + (lch >> 1) * 32 + (lch & 1) * 8 + 16) = (u32x2){vreg.z, vreg.w};
        if (kt + 1 < ntile) {
            kreg = *(const u32x4*)(Z + (size_t)((kt + 1) * 64 + lrow) * 1024 + 512 + lch * 8);
            vreg = *(const u32x4*)(VT + (size_t)lrow * SEQ + (kt + 1) * 64 + lch * 8);
        }
        __syncthreads();
        f32x16 p0, p1;
#pragma unroll
        for (int i = 0; i < 16; ++i) { p0[i] = 0.f; p1[i] = 0.f; }
#pragma unroll
        for (int ks = 0; ks < 4; ++ks) {
            const bf16x8 ka = *(const LAS bf16x8*)(Kb + r2 * 144 + ks * 32 + hi2 * 16);
            const bf16x8 kb2 = *(const LAS bf16x8*)(Kb + (32 + r2) * 144 + ks * 32 + hi2 * 16);
            p0 = __builtin_amdgcn_mfma_f32_32x32x16_bf16(ka, qf[ks], p0, 0, 0, 0);
            p1 = __builtin_amdgcn_mfma_f32_32x32x16_bf16(kb2, qf[ks], p1, 0, 0, 0);
        }
        const unsigned mw0 = maskL[(kt * 2) * 32 + r2], mw1 = maskL[(kt * 2 + 1) * 32 + r2];
        float mx = -INFINITY;
#pragma unroll
        for (int i = 0; i < 16; ++i) {
            const int bitp = crow(i, 0);
            p0[i] = ((mw0 >> (bitp + 4 * hi2)) & 1u) ? p0[i] : -INFINITY;
            p1[i] = ((mw1 >> (bitp + 4 * hi2)) & 1u) ? p1[i] : -INFINITY;
            mx = fmaxf(mx, fmaxf(p0[i], p1[i]));
        }
        mx = fmaxf(mx, __shfl_xor(mx, 32)) * qscale;
        const float m_new = fmaxf(m_run, mx);
        const float m_use = (m_new == -INFINITY) ? 0.f : m_new;
        const float alpha = __builtin_amdgcn_exp2f(m_run - m_use);
        float ps = 0.f;
#pragma unroll
        for (int i = 0; i < 16; ++i) { p0[i] = __builtin_amdgcn_exp2f(__builtin_fmaf(p0[i], qscale, -m_use)); p1[i] = __builtin_amdgcn_exp2f(__builtin_fmaf(p1[i], qscale, -m_use)); ps += p0[i] + p1[i]; }
        ps += __shfl_xor(ps, 32);
        l_run = l_run * alpha + ps; m_run = m_new;
        if (__builtin_amdgcn_ballot_w64(alpha != 1.0f) != 0ull) {
#pragma unroll
            for (int i = 0; i < 16; ++i) { o0[i] *= alpha; o1[i] *= alpha; }
        }
#pragma unroll
        for (int kb = 0; kb < 2; ++kb)
#pragma unroll
            for (int kk = 0; kk < 2; ++kk) {
                const f32x16& pp = kb ? p1 : p0;
                u32x4 pw;
                pw.x = cvt_pk_bf16(pp[8 * kk + 0], pp[8 * kk + 1]); pw.y = cvt_pk_bf16(pp[8 * kk + 2], pp[8 * kk + 3]);
                pw.z = cvt_pk_bf16(pp[8 * kk + 4], pp[8 * kk + 5]); pw.w = cvt_pk_bf16(pp[8 * kk + 6], pp[8 * kk + 7]);
                const bf16x8 pb = __builtin_bit_cast(bf16x8, pw);
                const int goff = (kb * 2 + kk) * 32 + hi2 * 16;
#pragma unroll
                for (int db = 0; db < 2; ++db) {
                    const bf16x8 vf = *(const LAS bf16x8*)(Vb + (db * 32 + r2) * 144 + goff);
                    if (db == 0) o0 = __builtin_amdgcn_mfma_f32_32x32x16_bf16(vf, pb, o0, 0, 0, 0);
                    else o1 = __builtin_amdgcn_mfma_f32_32x32x16_bf16(vf, pb, o1, 0, 0, 0);
                }
            }
    }
    {
        const float inv = 1.0f / l_run;
        bf16_t* op = (bf16_t*)(p.ws + WS_ATT) + (size_t)(b * SEQ + t0 + r2) * 512 + h * 64;
#pragma unroll
        for (int g4 = 0; g4 < 4; ++g4) {
            u32x2 w0, w1;
            w0.x = cvt_pk_bf16(o0[4 * g4 + 0] * inv, o0[4 * g4 + 1] * inv); w0.y = cvt_pk_bf16(o0[4 * g4 + 2] * inv, o0[4 * g4 + 3] * inv);
            w1.x = cvt_pk_bf16(o1[4 * g4 + 0] * inv, o1[4 * g4 + 1] * inv); w1.y = cvt_pk_bf16(o1[4 * g4 + 2] * inv, o1[4 * g4 + 3] * inv);
            *(u32x2*)(op + 8 * g4 + 4 * hi2) = w0;
            *(u32x2*)(op + 32 + 8 * g4 + 4 * hi2) = w1;
        }
    }
    __syncthreads();
}

constexpr int RN_Y = 0;
constexpr int RN_A = 36864;
constexpr int RN_U = RN_A + 32768;
constexpr int RN_SA = RN_U + 32768;
constexpr int RN_SH = RN_SA + 2048;
constexpr int RN_HI = RN_SH + 2048;
constexpr int RN_WF = RN_HI + 2048;
constexpr int RN_CW = RN_WF + 8192;
constexpr int RN_END = RN_CW + 1280;

__device__ __forceinline__ void rnn_item(LAS unsigned char* lds, const Params& p, int layer, int item, int wv) {
    MAKE_TID(wv);
    const int wid = __builtin_amdgcn_readfirstlane(tid >> 6), lane = tid & 63;
    const int b = item >> 5, n = (item >> 1) & 15, half = item & 1;
    const bf16_t* XR = (const bf16_t*)(p.ws + WS_XR0) + (size_t)b * SLAB_E + n * 64;
    bf16_t* GG = (bf16_t*)(p.ws + WS_GGR0) + (size_t)b * SLAB_E + n * 64 + half * 32;
    const float* cw = p.in[7] + (size_t)layer * 4 * 1024 + n * 64;
    const float* cb = p.in[8] + (size_t)layer * 1024 + n * 64;
    const float* wa = p.in[9] + ((size_t)layer * 16 + n) * 4096;
    const float* ba = p.in[10] + (size_t)layer * 1024 + n * 64 + half * 32;
    const float* wx = p.in[11] + ((size_t)layer * 16 + n) * 4096;
    const float* bx = p.in[12] + (size_t)layer * 1024 + n * 64 + half * 32;
    const float* lam = p.in[13] + (size_t)layer * 1024 + n * 64 + half * 32;
    LAS bf16_t* Y = (LAS bf16_t*)(lds + RN_Y);
    LAS float* As = (LAS float*)(lds + RN_A);
    LAS float* Us = (LAS float*)(lds + RN_U);
    LAS float* SA = (LAS float*)(lds + RN_SA);
    LAS float* SH = (LAS float*)(lds + RN_SH);
    LAS float* HI = (LAS float*)(lds + RN_HI);
    const int r = lane & 31, hi = lane >> 5;
    LAS u32x4* WF = (LAS u32x4*)(lds + RN_WF);
    if (wid == 0) {
#pragma unroll
        for (int ks = 0; ks < 4; ++ks) {
            unsigned wA[4], wX[4];
#pragma unroll
            for (int i = 0; i < 4; ++i) {
                const int k = ks * 16 + hi * 8 + 2 * i;
                wA[i] = cvt_pk_bf16(wa[(size_t)k * 64 + half * 32 + r], wa[(size_t)(k + 1) * 64 + half * 32 + r]);
                wX[i] = cvt_pk_bf16(wx[(size_t)k * 64 + half * 32 + r], wx[(size_t)(k + 1) * 64 + half * 32 + r]);
            }
            WF[(ks * 2 + 0) * 64 + lane] = (u32x4){wA[0], wA[1], wA[2], wA[3]};
            WF[(ks * 2 + 1) * 64 + lane] = (u32x4){wX[0], wX[1], wX[2], wX[3]};
        }
    }
    LAS float* CW = (LAS float*)(lds + RN_CW);
    if (tid < 256) CW[tid] = cw[(tid >> 6) * 1024 + (tid & 63)]; else if (tid < 320) CW[tid] = cb[tid - 256];
    const float bav = ba[r], bxv = bx[r];
    const float spl = log1pf(__expf(-lam[r]));
    float hcar = 0.f;
    __syncthreads();
    for (int tt = 0; tt < SEQ / 256; ++tt) {
        const int tb = tt * 256;
        {
            const int tok = tid >> 1, cg0 = (tid & 1) * 32, t = tb + tok;
#pragma unroll
            for (int hq = 0; hq < 2; ++hq) {
                u32x4 xw[2][4];
#pragma unroll
                for (int q8 = 0; q8 < 2; ++q8)
#pragma unroll
                    for (int j = 0; j < 4; ++j) { const int ts = t - 3 + j; xw[q8][j] = *(const u32x4*)(XR + (size_t)(ts < 0 ? 0 : ts) * 1024 + cg0 + (hq * 2 + q8) * 8); }
                __builtin_amdgcn_sched_barrier(0);
#pragma unroll
                for (int q8 = 0; q8 < 2; ++q8) {
                    const int c0 = cg0 + (hq * 2 + q8) * 8;
                    float y[8];
#pragma unroll
                    for (int i = 0; i < 8; ++i) y[i] = CW[256 + c0 + i];
#pragma unroll
                    for (int j = 0; j < 4; ++j) {
                        const float mk = (t - 3 + j) >= 0 ? 1.0f : 0.0f;
                        const u32x4 x4 = xw[q8][j];
                        const f32x4 w0 = *(const LAS f32x4*)(CW + j * 64 + c0) * mk, w1 = *(const LAS f32x4*)(CW + j * 64 + c0 + 4) * mk;
                        y[0] += w0[0] * bflo(x4.x); y[1] += w0[1] * bfhi(x4.x); y[2] += w0[2] * bflo(x4.y); y[3] += w0[3] * bfhi(x4.y);
                        y[4] += w1[0] * bflo(x4.z); y[5] += w1[1] * bfhi(x4.z); y[6] += w1[2] * bflo(x4.w); y[7] += w1[3] * bfhi(x4.w);
                    }
                    u32x4 w; w.x = cvt_pk_bf16(y[0], y[1]); w.y = cvt_pk_bf16(y[2], y[3]); w.z = cvt_pk_bf16(y[4], y[5]); w.w = cvt_pk_bf16(y[6], y[7]);
                    *(LAS u32x4*)(Y + tok * 72 + c0) = w;
                    if ((c0 >> 5) == half) {
#pragma unroll
                        for (int i = 0; i < 8; ++i) Us[tok * 32 + (c0 & 31) + i] = y[i];
                    }
                    __builtin_amdgcn_sched_barrier(0);
                }
            }
        }
        __syncthreads();
        {
            f32x16 ca, cx;
#pragma unroll
            for (int i = 0; i < 16; ++i) { ca[i] = 0.f; cx[i] = 0.f; }
#pragma unroll
            for (int ks = 0; ks < 4; ++ks) {
                const bf16x8 ya = *(const LAS bf16x8*)(Y + (wid * 32 + r) * 72 + ks * 16 + hi * 8);
                const bf16x8 fa = __builtin_bit_cast(bf16x8, WF[(ks * 2 + 0) * 64 + lane]), fx = __builtin_bit_cast(bf16x8, WF[(ks * 2 + 1) * 64 + lane]);
                ca = __builtin_amdgcn_mfma_f32_32x32x16_bf16(ya, fa, ca, 0, 0, 0);
                cx = __builtin_amdgcn_mfma_f32_32x32x16_bf16(ya, fx, cx, 0, 0, 0);
            }
#pragma unroll
            for (int i = 0; i < 16; ++i) {
                const int tok = wid * 32 + crow(i, hi);
                const float rg = sigmoidf_(ca[i] + bav), ig = sigmoidf_(cx[i] + bxv);
                const float la = -8.0f * rg * spl;
                const float a = __expf(la);
                const float mult = __builtin_amdgcn_sqrtf(fmaxf(1.0f - a * a, 0.f));
                const float yv = Us[tok * 32 + r];
                As[tok * 32 + r] = a;
                Us[tok * 32 + r] = mult * ig * yv;
            }
        }
        __syncthreads();
        const int sc = tid & 31, seg = tid >> 5;
        float av[16], uv[16];
#pragma unroll
        for (int k = 0; k < 16; ++k) { av[k] = As[(seg * 16 + k) * 32 + sc]; uv[k] = Us[(seg * 16 + k) * 32 + sc]; }
        bf16_t* gp0 = GG + (size_t)(tb + seg * 16) * 1024 + sc;
        float gv[16];
#pragma unroll
        for (int k = 0; k < 16; ++k) gv[k] = bf2f(gp0[(size_t)k * 1024]);
        {
            float A = 1.f, H = 0.f;
#pragma unroll
            for (int k = 0; k < 16; ++k) { A *= av[k]; H = av[k] * H + uv[k]; }
            SA[seg * 32 + sc] = A; SH[seg * 32 + sc] = H;
        }
        __syncthreads();
        float hin = 0.f;
        {
            float sa[16], sh[16];
#pragma unroll
            for (int s2 = 0; s2 < 16; ++s2) { sa[s2] = SA[s2 * 32 + sc]; sh[s2] = SH[s2 * 32 + sc]; }
            float hh = hcar;
#pragma unroll
            for (int s2 = 0; s2 < 16; ++s2) { if (s2 == seg) hin = hh; hh = sa[s2] * hh + sh[s2]; }
            hcar = hh;
        }
        {
            float hh = hin;
#pragma unroll
            for (int k = 0; k < 16; ++k) {
                hh = av[k] * hh + uv[k];
                gp0[(size_t)k * 1024] = (bf16_t)(cvt_pk_bf16(hh * gv[k], 0.f) & 0xffff);
            }
        }
        __syncthreads();
    }
}

__device__ __forceinline__ int opq(int v) { asm volatile("" : "+s"(v)); return v; }
#define XB_TMO      128
#define XB_XCNT(j)  (256  + 64 * (j))
#define XB_XSUB(j)  (1280 + 64 * (j))
#define XB_XGEN(j)  (2304 + 64 * (j))
#define XB_TOP      3328
#define XB_TOPGEN   3392
#define XCD_BAR_WORDS 3456
#define XB_SPIN_CAP (1u << 20)
__device__ __forceinline__ unsigned xb_ld(unsigned* p)              { return __hip_atomic_load(p, __ATOMIC_RELAXED, __HIP_MEMORY_SCOPE_AGENT); }
__device__ __forceinline__ unsigned xb_add(unsigned* p, unsigned v) { return __hip_atomic_fetch_add(p, v, __ATOMIC_RELAXED, __HIP_MEMORY_SCOPE_AGENT); }
__device__ __forceinline__ unsigned xb_xcc_id() { return (unsigned)__builtin_amdgcn_s_getreg((3 << 11) | 20) & 0xFu; }
#define XB_SPIN(cond, bar) do { unsigned _sp = 0; while (cond) { __builtin_amdgcn_s_sleep(1); \
    if ((++_sp & 255u) == 0u) { if (xb_ld(&(bar)[XB_TMO])) break; if (_sp > XB_SPIN_CAP) { atomicAdd(&(bar)[XB_TMO], 1u); break; } } } } while (0)
__device__ __forceinline__ void xcd_barrier_complete(unsigned* bar, unsigned x, unsigned& nloc, unsigned& nx) {
    const unsigned G = gridDim.x;
    unsigned sum, cnt, mine, sp = 0u;
    for (;;) {
        sum = 0u; cnt = 0u; mine = 0u;
#pragma unroll
        for (unsigned j = 0; j < 16; ++j) { const unsigned c = xb_ld(&bar[XB_XCNT(j)]); sum += c; cnt += (c > 0u) ? 1u : 0u; mine = (j == x) ? c : mine; }
        if (sum == G) break;
        __builtin_amdgcn_s_sleep(1);
        if ((++sp & 255u) == 0u) { if (xb_ld(&bar[XB_TMO])) break; if (sp > XB_SPIN_CAP) { atomicAdd(&bar[XB_TMO], 1u); break; } }
    }
    nloc = mine > 0u ? mine : 1u; nx = cnt > 0u ? cnt : 1u;
}
__device__ __forceinline__ void grid_barrier(unsigned* bar, unsigned xcc, volatile LAS unsigned* st, int wv, bool glob) {
    asm volatile("" : "+s"(xcc));
    asm volatile("s_waitcnt vmcnt(0)" ::: "memory");
    __syncthreads();
    int ln = lane_id_(); asm volatile("" : "+v"(ln)); asm volatile("" : "+s"(wv));
    if (wv == 0 && ln == 0) {
        __builtin_amdgcn_s_waitcnt(0);
        unsigned nloc = st[0], nx = st[1];
        if (nloc == 0u) { xcd_barrier_complete(bar, xcc, nloc, nx); st[0] = nloc; st[1] = nx; }
        const unsigned old = xb_add(&bar[XB_XSUB(xcc)], 1u);
        const unsigned gen = old / nloc;
        if (old + 1u == (gen + 1u) * nloc) {
            if (glob) {
                __builtin_amdgcn_fence(__ATOMIC_RELEASE, "agent");
                asm volatile("s_waitcnt vmcnt(0)" ::: "memory");
                const unsigned og = xb_add(&bar[XB_TOP], 1u);
                const unsigned tg = og / nx;
                if (og + 1u == (tg + 1u) * nx) xb_add(&bar[XB_TOPGEN], 1u);
                else XB_SPIN(xb_ld(&bar[XB_TOPGEN]) == tg, bar);
            }
            __builtin_amdgcn_fence(__ATOMIC_ACQUIRE, "agent");
            xb_add(&bar[XB_XGEN(xcc)], 1u);
            asm volatile("s_waitcnt vmcnt(0)" ::: "memory");
        } else {
            XB_SPIN(xb_ld(&bar[XB_XGEN(xcc)]) == gen, bar);
            __builtin_amdgcn_fence(__ATOMIC_ACQUIRE, "agent");
            asm volatile("s_waitcnt vmcnt(0)" ::: "memory");
        }
    }
    __syncthreads();
}
__device__ __forceinline__ void panel_barrier(unsigned* gw, unsigned* bar, unsigned target, int wv) {
    asm volatile("s_waitcnt vmcnt(0)" ::: "memory");
    __syncthreads();
    int ln = lane_id_(); asm volatile("" : "+v"(ln)); asm volatile("" : "+s"(wv));
    if (wv == 0 && ln == 0) {
        (void)xb_add(gw, 1u);
        XB_SPIN(xb_ld(gw) < target, bar);
        __builtin_amdgcn_fence(__ATOMIC_ACQUIRE, "agent");
        asm volatile("s_waitcnt vmcnt(0)" ::: "memory");
    }
    __syncthreads();
}
__device__ __forceinline__ void cvt_publish(unsigned* flag, int wv) {
    asm volatile("s_waitcnt vmcnt(0)" ::: "memory");
    __syncthreads();
    int ln = lane_id_(); asm volatile("" : "+v"(ln)); asm volatile("" : "+s"(wv));
    if (wv == 0 && ln == 0) { __builtin_amdgcn_fence(__ATOMIC_RELEASE, "agent"); asm volatile("s_waitcnt vmcnt(0)" ::: "memory"); (void)xb_add(flag, 1u); }
}
__device__ __forceinline__ void cvt_wait(unsigned* flag, unsigned* bar, unsigned want, int wv) {
    int ln = lane_id_(); asm volatile("" : "+v"(ln)); asm volatile("" : "+s"(wv));
    if (wv == 0 && ln == 0) { XB_SPIN(xb_ld(flag) < want, bar); __builtin_amdgcn_fence(__ATOMIC_ACQUIRE, "agent"); asm volatile("s_waitcnt vmcnt(0)" ::: "memory"); }
    __syncthreads();
}
__device__ __forceinline__ void block_seam(int wv) {
    asm volatile("s_waitcnt vmcnt(0)" ::: "memory");
    __syncthreads();
    int ln = lane_id_(); asm volatile("" : "+v"(ln)); asm volatile("" : "+s"(wv));
    if (wv == 0 && ln == 0) { __builtin_amdgcn_fence(__ATOMIC_ACQUIRE, "agent"); asm volatile("s_waitcnt vmcnt(0)" ::: "memory"); }
    __syncthreads();
}
#define GRID_SYNC() do { grid_barrier(bar_ctr, xcc_id, bar_st, wv, true); } while (0)
#define GRID_SYNC_P() do { if (fastp) panel_barrier(grp_ctr, bar_ctr, 4u * (++grp_k), wv); else grid_barrier(bar_ctr, xcc_id, bar_st, wv, true); } while (0)
#define GRID_SYNC_L() do { grid_barrier(bar_ctr, xcc_id, bar_st, wv, !fastp); } while (0)
#define Wgu1_(l) ((const bf16_t*)(ws + WS_WGU) + (size_t)(l * 2 + 0) * NGU * DM)
#define Wgu2_(l) ((const bf16_t*)(ws + WS_WGU) + (size_t)(l * 2 + 1) * NGU * DM)
#define Wd1_(l) ((const bf16_t*)(ws + WS_WD) + (size_t)(l * 2 + 0) * DM * DFF)
#define Wd2_(l) ((const bf16_t*)(ws + WS_WD) + (size_t)(l * 2 + 1) * DM * DFF)
#define Win_(l) ((const bf16_t*)(ws + WS_WIN) + (size_t)l * NWIN * DM)
#define Wap_(l) ((const bf16_t*)(ws + WS_WAP) + (size_t)l * DM * 512)
#define Wrp_(l) ((const bf16_t*)(ws + WS_WRP) + (size_t)l * DM * DM)
#define Wo_(l) ((const bf16_t*)(ws + WS_WO) + (size_t)l * DM * DM)
__global__ void __launch_bounds__(512, 2) fwd_megakernel(Params p) {
    extern __shared__ __attribute__((aligned(16))) unsigned char lds_raw[];
    LAS unsigned char* lds = (LAS unsigned char*)lds_raw;
    cg::grid_group grid = cg::this_grid();
    const int G = gridDim.x;
    const int wv = __builtin_amdgcn_readfirstlane((int)(threadIdx.x >> 6));
    unsigned char* ws = p.ws;
    unsigned* bar_ctr = (unsigned*)(ws + WS_BAR);
    volatile LAS unsigned* bar_st = (volatile LAS unsigned*)(lds + LDS_BYTES - 16);
    const unsigned xcc_id = xb_xcc_id();
    if (threadIdx.x == 0) { bar_st[0] = 0u; bar_st[1] = 0u; bar_st[2] = xb_add(&bar_ctr[XB_XCNT(xcc_id)], 1u); }
    __syncthreads();
    const bool split_cvt = (G == 256);
    convert_jobs(lds, p, wv, 0, split_cvt ? 2 : 16, G, (int)blockIdx.x);
    asm volatile("s_waitcnt vmcnt(0)" ::: "memory");
    grid.sync();
    __builtin_amdgcn_fence(__ATOMIC_ACQUIRE, "agent"); asm volatile("s_waitcnt vmcnt(0)" ::: "memory");
    if (threadIdx.x == 0) {
        bool ok = (G % 8 == 0);
#pragma unroll
        for (unsigned j = 0; j < 16; ++j) { const unsigned cn = xb_ld(&bar_ctr[XB_XCNT(j)]); ok = ok && (cn == (j < 8u ? (unsigned)G / 8u : 0u)); }
        bar_st[3] = ok ? 1u : 0u;
    }
    __syncthreads();
    const bool fastp = __builtin_amdgcn_readfirstlane((int)bar_st[3]) != 0;
    const int c = fastp ? __builtin_amdgcn_readfirstlane((int)(bar_st[2] * 8u + xcc_id)) : (int)blockIdx.x;
    unsigned* grp_ctr = bar_ctr + 4096 + 64 * (xcc_id * 8u + (((unsigned)c >> 3) & 7u)); unsigned grp_k = 0u;
    bf16_t* XB = (bf16_t*)(ws + WS_XB); float* SSQ = (float*)(ws + WS_SSQ);
    bf16_t* Hb = (bf16_t*)(ws + WS_R); bf16_t* QKV = (bf16_t*)(ws + WS_QKV0); bf16_t* XRb = (bf16_t*)(ws + WS_XR0); bf16_t* GGR = (bf16_t*)(ws + WS_GGR0); bf16_t* VT = (bf16_t*)(ws + WS_VT0);
    pg8::StaticOrder S;

    phase_xb(p, opq(wv), c);
    GRID_SYNC_L();

    for (int l = 0; l < 2; ++l) {
        if (split_cvt && l == 1) cvt_wait(bar_ctr + 8192 + 64 * 2, bar_ctr, 128u, wv);
        { pg8::Gemm g{XB, Wgu1_(l), MTOK, NGU, DM, DM, DM}; S.init(MTOK, NGU, G, opq(c)); EpiSwiGLU E{Hb, SSQ}; pg8::gemm_phase(lds, g, S, E, wv); }
        if (split_cvt && c >= 128) { if (l == 0) convert_jobs(lds, p, opq(wv), 2, 8, 128, c - 128); else convert_jobs(lds, p, opq(wv), 14, 16, 128, c - 128); cvt_publish(bar_ctr + 8192 + 64 * (l == 0 ? 1 : 3), wv); }
        GRID_SYNC_P();
        { pg8::Gemm g{Hb, Wd1_(l), MTOK, DM, DFF, DFF, DFF, GAP_H}; S.init(MTOK, DM, G, opq(c)); EpiResid E{l == 0 ? p.in[0] : p.out, p.out, XB, SSQ, 0.5f}; pg8::gemm_phase(lds, g, S, E, wv); }
        GRID_SYNC_L();
        if (split_cvt && l == 0) cvt_wait(bar_ctr + 8192 + 64 * 1, bar_ctr, 128u, wv);
        { pg8::Gemm g{XB, Win_(l), MTOK, 3072, DM, DM, DM}; S.init(MTOK, 3072, G, opq(c)); EpiWin1 E{QKV, VT, (bf16_t*)(ws + WS_KI), SSQ}; pg8::gemm_phase(lds, g, S, E, wv); }
        GRID_SYNC_L();
        for (int it = c; it < 512; it += G) {
            const int j = (it >> 3) & 31, b = it & 7, qb = (it >= 256) ? 63 - j : j;
            attn_item(lds, p, qb * 8 + b, wv);
        }
        for (int it = c; it < 256; it += G) rnn_item(lds, p, l, ((it & 7) << 5) | (it >> 3), wv);
        GRID_SYNC_L();
        { pg8::Gemm g{XB, Win_(l) + (size_t)3072 * DM, MTOK, 2048, DM, DM, DM}; S.init(MTOK, 2048, G, opq(c)); EpiSig E{XRb, QKV, SSQ}; pg8::gemm_phase(lds, g, S, E, wv); }
        block_seam(wv);
        { pg8::Gemm g{(const bf16_t*)(ws + WS_ATT), Wap_(l), MTOK, DM, 512, 512, 512}; S.init(MTOK, DM, G, opq(c)); EpiGate<0> E{XRb, XRb}; pg8::gemm_phase(lds, g, S, E, wv); }
        { pg8::Gemm g{GGR, Wrp_(l), MTOK, DM, DM, DM, DM, GAP_P}; S.init(MTOK, DM, G, opq(c)); EpiGate<1> E{XRb, QKV}; pg8::gemm_phase(lds, g, S, E, wv); }
        GRID_SYNC_P();
        { pg8::Gemm g{XRb, Wo_(l), MTOK, DM, DM, DM, DM, GAP_P}; S.init(MTOK, DM, G, opq(c)); EpiResid E{p.out, p.out, XB, SSQ, 1.0f}; pg8::gemm_phase(lds, g, S, E, wv); }
        GRID_SYNC_L();
        if (split_cvt && l == 1) cvt_wait(bar_ctr + 8192 + 64 * 3, bar_ctr, 128u, wv);
        { pg8::Gemm g{XB, Wgu2_(l), MTOK, NGU, DM, DM, DM}; S.init(MTOK, NGU, G, opq(c)); EpiSwiGLU E{Hb, SSQ}; pg8::gemm_phase(lds, g, S, E, wv); }
        if (split_cvt && c >= 128 && l == 0) { convert_jobs(lds, p, opq(wv), 8, 14, 128, c - 128); cvt_publish(bar_ctr + 8192 + 64 * 2, wv); }
        GRID_SYNC_P();
        if (fastp && l == 1) {
            pg8::Gemm g{Hb, Wd2_(l), MTOK, DM, DFF, DFF, DFF, GAP_H}; S.init(MTOK, DM, G, opq(c)); const unsigned tg = 4u * (++grp_k);
            EpiResidFinal E{p.out, p.out, SSQ, p.in[21], 0.5f, grp_ctr, bar_ctr, tg, wv}; pg8::gemm_phase(lds, g, S, E, wv);
        } else {
            { pg8::Gemm g{Hb, Wd2_(l), MTOK, DM, DFF, DFF, DFF, GAP_H}; S.init(MTOK, DM, G, opq(c)); EpiResid E{p.out, p.out, XB, SSQ, 0.5f}; pg8::gemm_phase(lds, g, S, E, wv); }
            if (l == 0) GRID_SYNC_P(); else GRID_SYNC_L();
        }
    }
    if (!fastp) phase_final(p, wv, c);
}

extern "C" void kernel_launch(void* const* d_in, const int* in_sizes, int n_in, void* d_out, int out_size, void* d_ws, size_t ws_size, hipStream_t stream) {
    static int grid_blocks = 0;
    if (grid_blocks == 0) {
        if (n_in != 22 || out_size != MTOK * DM || ws_size < WS_END) { fprintf(stderr, "kernel_launch: unexpected sizes n_in %d out %d ws %zu (need %zu)\n", n_in, out_size, ws_size, (size_t)WS_END); grid_blocks = -1; return; }
        int dev = 0, cus = 0, per_cu = 0;
        hipGetDevice(&dev);
        hipDeviceGetAttribute(&cus, hipDeviceAttributeMultiprocessorCount, dev);
        if (hipFuncSetAttribute((const void*)fwd_megakernel, hipFuncAttributeMaxDynamicSharedMemorySize, LDS_BYTES) != hipSuccess) { fprintf(stderr, "kernel_launch: hipFuncSetAttribute failed\n"); grid_blocks = -1; return; }
        hipOccupancyMaxActiveBlocksPerMultiprocessor(&per_cu, (const void*)fwd_megakernel, 512, LDS_BYTES);
        if (per_cu < 1) { fprintf(stderr, "kernel_launch: occupancy query says %d blocks per CU\n", per_cu); grid_blocks = -1; return; }
        grid_blocks = cus * (per_cu > 1 ? 1 : per_cu);
    }
    if (grid_blocks < 0) return;
    Params p{};
    for (int i = 0; i < 22; ++i) p.in[i] = (const float*)d_in[i];
    p.out = (float*)d_out; p.ws = (unsigned char*)d_ws;
    if (hipMemsetAsync((char*)d_ws + WS_BAR, 0, 49152, stream) != hipSuccess) { fprintf(stderr, "kernel_launch: memset failed\n"); return; }
    void* args[] = {&p};
    hipError_t e = hipLaunchCooperativeKernel((const void*)fwd_megakernel, dim3(grid_blocks), dim3(512), args, LDS_BYTES, stream);
    if (e != hipSuccess) fprintf(stderr, "cooperative launch failed: %s (grid %d)\n", hipGetErrorString(e), grid_blocks);
}
```
